# Optimizing an MI355X kernel written in HIP

```python
import math
import jax, jax.numpy as jnp
from jax import lax
import numpy as np

D_MODEL = 1024
BATCH = 8
SEQ = 2048
DEPTH = 1
DEC_BATCH = 8
DEC_SEQ = 8192
PAST_LEN = 128

HG_HEADS = 4
HG_HEAD_DIM = 128
HG_WIDTH = HG_HEADS * HG_HEAD_DIM
HG_CHUNK = 64
HG_SCALE = HG_HEAD_DIM ** -0.5
DA_HEADS = 4
DA_HEAD_DIM = 64
DA_V_DIM = 2 * DA_HEAD_DIM
DA_QK_WIDTH = DA_HEADS * 2 * DA_HEAD_DIM
DA_V_WIDTH = DA_HEADS * DA_V_DIM
DA_SCALE = DA_HEAD_DIM ** -0.5
Q_BLOCK = 128
ROT_DIM = DA_HEAD_DIM // 4
ROPE_THETA = 500000.0
D_FF = 4 * D_MODEL
NORM_EPS = 1e-6
SUBLN_EPS = 1e-5
IN_SIZES = (DA_QK_WIDTH, DA_QK_WIDTH, DA_V_WIDTH,
            HG_WIDTH, HG_WIDTH, HG_WIDTH, HG_WIDTH, HG_WIDTH,
            D_MODEL, D_MODEL)
IN_WIDTH = 3 * 512 + 5 * HG_WIDTH + 2 * D_MODEL

kernel_name = 'hgrn2_diffattn_parallel_encoder'

F32 = jnp.float32


def _rmsnorm(x, g, eps=NORM_EPS):
    xf = x.astype(F32)
    y = xf * lax.rsqrt(jnp.mean(xf * xf, axis=-1, keepdims=True) + eps) * g.astype(F32)
    return y.astype(x.dtype)


def _gla_chunkwise(q, k, v, log_f):
    B, H, T, dk = q.shape
    dv = v.shape[-1]
    n = T // HG_CHUNK

    def chunks(a):
        return a.reshape(B, H, n, HG_CHUNK, a.shape[-1]).transpose(2, 0, 1, 3, 4)

    qc, kc, vc = chunks(q), chunks(k), chunks(v)
    gc = jnp.cumsum(chunks(log_f), axis=3)
    mask = jnp.tril(jnp.ones((HG_CHUNK, HG_CHUNK), dtype=bool))[:, :, None]

    def step(S, inp):
        q_, k_, v_, g_ = inp
        diff = g_[:, :, :, None, :] - g_[:, :, None, :, :]
        decay = jnp.exp(jnp.where(mask, diff, -jnp.inf))
        a = jnp.einsum('bhtk,bhsk,bhtsk->bhts', q_, k_, decay)
        o = (jnp.einsum('bhts,bhsv->bhtv', a, v_)
             + jnp.einsum('bhtk,bhkv->bhtv', q_ * jnp.exp(g_), S))
        g_last = g_[:, :, -1:, :]
        S = (S * jnp.exp(g_last[:, :, 0, :])[..., None]
             + jnp.einsum('bhsk,bhsv->bhkv', k_ * jnp.exp(g_last - g_), v_))
        return S, o

    S0 = jnp.zeros((B, H, dk, dv), F32)
    _, o = lax.scan(step, S0, (qc, kc, vc, gc))
    return o.transpose(1, 2, 0, 3, 4).reshape(B, H, T, dv)


def _partial_rotary(x, pos):
    half = ROT_DIM // 2
    inv_freq = ROPE_THETA ** (-jnp.arange(0, ROT_DIM, 2, dtype=F32) / ROT_DIM)
    ang = pos[:, None] * inv_freq[None, :]
    cos, sin = jnp.cos(ang), jnp.sin(ang)
    x1, x2, xp = x[..., :half], x[..., half:ROT_DIM], x[..., ROT_DIM:]
    return jnp.concatenate([x1 * cos - x2 * sin, x2 * cos + x1 * sin, xp], axis=-1)


def _diff_attention(q, k, v, lam):
    B, H2, T, d = q.shape
    H = H2 // 2
    nb = T // Q_BLOCK
    qb = q.reshape(B, H2, nb, Q_BLOCK, d).transpose(2, 0, 1, 3, 4)

    def block(qi):
        s = jnp.einsum('bhqd,bhkd->bhqk', qi, k) * DA_SCALE
        p = jax.nn.softmax(s, axis=-1).reshape(B, H, 2, Q_BLOCK, T)
        w = p[:, :, 0] - lam * p[:, :, 1]
        return jnp.einsum('bhqk,bhkv->bhqv', w, v)

    o = lax.map(block, qb)
    return o.transpose(1, 2, 0, 3, 4).reshape(B, H, T, v.shape[-1])


def _layer(x, pos, lidx, norm1, w_in, hg_lb_logits, hg_norm, w_hg_branch,
           lq1, lk1, lq2, lk2, da_subln, w_da_branch, w_out, norm2, w_mlp_in, w_mlp_out):
    B, T, _ = x.shape
    h = _rmsnorm(x, norm1)
    u = h @ w_in
    offs = np.cumsum(np.array(IN_SIZES))[:-1].tolist()
    q_da, k_da, v_da, q_hg, f_fw, f_bw, i_hg, g_hg, gate_hg, gate_da = jnp.split(u, offs, axis=-1)

    lb = jnp.cumsum(jax.nn.softmax(hg_lb_logits.astype(F32), axis=1), axis=1)[:, lidx]
    ff = lb[0] + (1.0 - lb[0]) * jax.nn.sigmoid(f_fw.astype(F32))
    fb = lb[1] + (1.0 - lb[1]) * jax.nn.sigmoid(f_bw.astype(F32))

    def heads(a):
        return a.reshape(B, T, HG_HEADS, HG_HEAD_DIM).transpose(0, 2, 1, 3)

    def rev(a):
        return jnp.flip(a, axis=2)

    q = heads(jax.nn.silu(q_hg.astype(F32)) * HG_SCALE)
    i = heads(i_hg.astype(F32))
    ff, fb = heads(ff), heads(fb)
    o = _gla_chunkwise(jnp.concatenate([q, rev(q)], axis=1),
                       jnp.concatenate([1.0 - ff, rev(1.0 - fb)], axis=1),
                       jnp.concatenate([i, rev(i)], axis=1),
                       jnp.concatenate([jnp.log(ff), rev(jnp.log(fb))], axis=1))
    o = o[:, :HG_HEADS] + rev(o[:, HG_HEADS:])
    o = _rmsnorm(o.transpose(0, 2, 1, 3), hg_norm.reshape(HG_HEADS, HG_HEAD_DIM))
    o = o.reshape(B, T, HG_WIDTH) * jax.nn.silu(g_hg.astype(F32))
    y_hg = o.astype(x.dtype) @ w_hg_branch

    lam_init = 0.8 - 0.6 * math.exp(-0.3 * lidx)
    lam = (jnp.exp(jnp.sum(lq1.astype(F32) * lk1.astype(F32)))
           - jnp.exp(jnp.sum(lq2.astype(F32) * lk2.astype(F32))) + lam_init)
    qa = q_da.astype(F32).reshape(B, T, 2 * DA_HEADS, DA_HEAD_DIM).transpose(0, 2, 1, 3)
    ka = k_da.astype(F32).reshape(B, T, 2 * DA_HEADS, DA_HEAD_DIM).transpose(0, 2, 1, 3)
    va = v_da.astype(F32).reshape(B, T, DA_HEADS, DA_V_DIM).transpose(0, 2, 1, 3)
    oa = _diff_attention(_partial_rotary(qa, pos), _partial_rotary(ka, pos), va, lam)
    oa = _rmsnorm(oa, da_subln, SUBLN_EPS) * (1.0 - lam_init)
    oa = oa.transpose(0, 2, 1, 3).reshape(B, T, DA_V_WIDTH)
    y_da = oa.astype(x.dtype) @ w_da_branch

    m = (jax.nn.sigmoid(gate_hg.astype(F32)) * y_hg.astype(F32)
         + jax.nn.sigmoid(gate_da.astype(F32)) * y_da.astype(F32))
    x = x + m.astype(x.dtype) @ w_out

    h2 = _rmsnorm(x, norm2)
    x = x + jnp.square(jax.nn.relu(h2 @ w_mlp_in)) @ w_mlp_out
    return x


def _trunk(x, norm1, w_in, hg_lb_logits, hg_norm, w_hg_branch, da_lambda_q1, da_lambda_k1,
           da_lambda_q2, da_lambda_k2, da_subln, w_da_branch, w_out, norm2, w_mlp_in,
           w_mlp_out, final_norm):
    pos = jnp.arange(x.shape[1], dtype=F32)
    for l in range(DEPTH):
        x = _layer(x, pos, l, norm1[l], w_in[l], hg_lb_logits, hg_norm[l], w_hg_branch[l],
                   da_lambda_q1[l], da_lambda_k1[l], da_lambda_q2[l], da_lambda_k2[l],
                   da_subln[l], w_da_branch[l], w_out[l], norm2[l], w_mlp_in[l], w_mlp_out[l])
    return _rmsnorm(x, final_norm)


def setup_inputs(seed: int = 0) -> dict:
    key = jax.random.key(seed)
    ks = jax.random.split(key, 18)

    def nrm(k, shape, scale):
        return jax.random.normal(k, shape, F32) * scale

    return {
        'x_prompt': nrm(ks[0], (BATCH, SEQ, D_MODEL), 1.0),
        'x_sample': nrm(ks[1], (DEC_BATCH, DEC_SEQ, D_MODEL), 1.0),
        'norm1': 1.0 + nrm(ks[2], (DEPTH, D_MODEL), 0.02),
        'w_in': nrm(ks[3], (DEPTH, D_MODEL, IN_WIDTH), D_MODEL ** -0.5),
        'hg_lb_logits': nrm(ks[4], (2, DEPTH + 1, HG_WIDTH), 1.0),
        'hg_norm': 1.0 + nrm(ks[5], (DEPTH, HG_WIDTH), 0.02),
        'w_hg_branch': nrm(ks[6], (DEPTH, HG_WIDTH, D_MODEL), HG_WIDTH ** -0.5),
        'da_lambda_q1': nrm(ks[7], (DEPTH, DA_HEAD_DIM), 0.1),
        'da_lambda_k1': nrm(ks[8], (DEPTH, DA_HEAD_DIM), 0.1),
        'da_lambda_q2': nrm(ks[9], (DEPTH, DA_HEAD_DIM), 0.1),
        'da_lambda_k2': nrm(ks[10], (DEPTH, DA_HEAD_DIM), 0.1),
        'da_subln': 1.0 + nrm(ks[11], (DEPTH, DA_V_DIM), 0.02),
        'w_da_branch': nrm(ks[12], (DEPTH, DA_V_WIDTH, D_MODEL), DA_V_WIDTH ** -0.5),
        'w_out': nrm(ks[13], (DEPTH, D_MODEL, D_MODEL), D_MODEL ** -0.5),
        'norm2': 1.0 + nrm(ks[14], (DEPTH, D_MODEL), 0.02),
        'w_mlp_in': nrm(ks[15], (DEPTH, D_MODEL, D_FF), D_MODEL ** -0.5),
        'w_mlp_out': nrm(ks[16], (DEPTH, D_FF, D_MODEL), D_FF ** -0.5),
        'final_norm': 1.0 + nrm(ks[17], (D_MODEL,), 0.02),
    }


def reference(x_prompt, x_sample, norm1, w_in, hg_lb_logits, hg_norm, w_hg_branch,
              da_lambda_q1, da_lambda_k1, da_lambda_q2, da_lambda_k2, da_subln, w_da_branch,
              w_out, norm2, w_mlp_in, w_mlp_out, final_norm):
    y_prompt = _trunk(x_prompt, norm1, w_in, hg_lb_logits, hg_norm, w_hg_branch, da_lambda_q1,
                      da_lambda_k1, da_lambda_q2, da_lambda_k2, da_subln, w_da_branch, w_out,
                      norm2, w_mlp_in, w_mlp_out, final_norm)
    y_sample = _trunk(x_sample, norm1, w_in, hg_lb_logits, hg_norm, w_hg_branch, da_lambda_q1,
                      da_lambda_k1, da_lambda_q2, da_lambda_k2, da_subln, w_da_branch, w_out,
                      norm2, w_mlp_in, w_mlp_out, final_norm)
    return (y_prompt, y_sample)
```

```cpp
#include <hip/hip_runtime.h>
#include <hip/hip_cooperative_groups.h>
#include <cstdio>
#include <cstdint>
namespace cg = cooperative_groups;
namespace pg8 {
#define PG8_LAS __attribute__((address_space(3)))
typedef unsigned short bf16_t;
typedef short bf16x8 __attribute__((ext_vector_type(8)));
typedef float f32x4 __attribute__((ext_vector_type(4)));
typedef unsigned u32x4 __attribute__((ext_vector_type(4)));
constexpr int BM = 256, BK = 64, HALF = 128, HTB = HALF * BK * 2  , STAGE_BYTES = 8 * HTB, NXCD = 8, WGM = 8;

__host__ __device__ __forceinline__ int lds_byte(int r, int c) { const int st = (r >> 4) * 2 + (c >> 5), rr = r & 15, cc = c & 31, ob = rr * 64 + cc * 2; return st * 1024 + (ob ^ (((ob >> 9) & 1) << 5)); }
__host__ __device__ __forceinline__ void stage_rc(int b, int& R, int& C) { const int st = b / 1024, sb = b % 1024, swz = sb ^ (((sb >> 9) & 1) << 5); R = (st >> 1) * 16 + swz / 64; C = (st & 1) * 32 + (swz % 64) / 2; }
__host__ __device__ __forceinline__ int perm32(int rho) { const int n = rho >> 4, i = rho & 15; return 8 * (i >> 2) + 4 * n + (i & 3); }

struct Unit { int pm, pn; };
struct Gemm { const bf16_t* A; const bf16_t* Bt; int M, N, K; };

struct StaticOrder {
    int nM, nN, nwg, G, c;
    __host__ __device__ void init(int M, int N, int G_, int c_) { nM = M / BM; nN = N / BM; nwg = nM * nN; G = G_; c = c_; }
    __host__ __device__ bool next(int i, Unit& u) const {
        const long L = (long)i * G + c; if (L >= nwg) return false;
        int wgid = (int)L; { const int q = nwg / NXCD, r = nwg % NXCD, xcd = wgid % NXCD, off = wgid / NXCD; wgid = (xcd < r ? xcd * (q + 1) : r * (q + 1) + (xcd - r) * q) + off; }
        const int nig = WGM * nN, gid = wgid / nig, fm = gid * WGM, gsz = (nM - fm) < WGM ? (nM - fm) : WGM;
        u.pm = fm + ((wgid % nig) % gsz); u.pn = (wgid % nig) / gsz; return true;
    }
    __device__ __forceinline__ void a_ready(const Unit&) const {}
    __device__ __forceinline__ void done(const Unit&) const {}
};

__device__ __forceinline__ unsigned cvt_pk_bf16(float lo, float hi) { unsigned r; asm volatile("v_cvt_pk_bf16_f32 %0, %1, %2" : "=v"(r) : "v"(lo), "v"(hi)); return r; }
template <class Epi, class Sched, bool ALIGN_EPI = false, bool SP2 = false>
__device__ __forceinline__ void gemm_phase(PG8_LAS unsigned char* lds, const Gemm g, const Sched& S, const Epi& E) {
    int tid_ = threadIdx.x; asm volatile("" : "+v"(tid_)); const int tid = tid_, wid = __builtin_amdgcn_readfirstlane(tid >> 6), lane = tid & 63, wr = wid >> 2, wc = wid & 3, fr = lane & 15, fq = lane >> 4;
    const int K = g.K, nt = K / BK;
    unsigned voffA[2], voffB[2];
#pragma unroll
    for (int i = 0; i < 2; ++i) { int R, C; stage_rc(tid * 16 + i * 8192, R, C); const int Rb = Epi::PERM ? ((R & ~31) + perm32(R & 31)) : R;
        voffA[i] = (unsigned)(R * K + C) * 2u; voffB[i] = (unsigned)(Rb * K + C) * 2u; }
    const size_t kstep = (size_t)(BK * 2);
    const size_t hstep = (size_t)HALF * K * 2;
    const size_t tstep = 2 * hstep;
    const unsigned ldsw = (unsigned)wid * 1024u;
    const int aoff = lds_byte(wr * 64 + fr, fq * 8), boff = lds_byte(wc * 32 + fr, fq * 8);
#define PG8_SA(b, h) (((b) * 2 + (h)) * HTB)
#define PG8_SB(b, h) ((4 + (b) * 2 + (h)) * HTB)
#define PG8_STAGE(bufoff, gbase, voff) do { _Pragma("unroll") for (int _i = 0; _i < 2; ++_i) \
        __builtin_amdgcn_global_load_lds((const unsigned*)((const char*)(gbase) + (voff)[_i]), (PG8_LAS unsigned*)(lds + (bufoff) + ldsw + _i * 8192), 16, 0, 0); } while (0)
#define PG8_LDA(dst, b, h) do { _Pragma("unroll") for (int m = 0; m < 4; ++m) _Pragma("unroll") for (int k = 0; k < 2; ++k) dst[m][k] = *(const PG8_LAS bf16x8*)(lds + PG8_SA(b, h) + aoff + m * 2048 + k * 1024); } while (0)
#define PG8_LDB(dst, b, h) do { _Pragma("unroll") for (int n = 0; n < 2; ++n) _Pragma("unroll") for (int k = 0; k < 2; ++k) dst[n][k] = *(const PG8_LAS bf16x8*)(lds + PG8_SB(b, h) + boff + n * 2048 + k * 1024); } while (0)
#define PG8_MMA(ai, bj, At, Bt) do { __builtin_amdgcn_s_setprio(1); _Pragma("unroll") for (int m = 0; m < 4; ++m) _Pragma("unroll") for (int n = 0; n < 2; ++n) _Pragma("unroll") for (int k = 0; k < 2; ++k) \
        acc[ai][bj][m][n] = __builtin_amdgcn_mfma_f32_16x16x32_bf16(Bt[n][k], At[m][k], acc[ai][bj][m][n], 0, 0, 0); __builtin_amdgcn_s_setprio(0); } while (0)
#define PG8_WAIT_V(n) asm volatile("s_waitcnt vmcnt(" #n ")" ::: "memory")
#define PG8_WAIT_L(n) asm volatile("s_waitcnt lgkmcnt(" #n ")" ::: "memory")
#define PG8_BAR __builtin_amdgcn_s_barrier()
#define PG8_SCHED __builtin_amdgcn_sched_barrier(0)
    Unit cur, nxt; int ui = 0;
    if (!S.next(0, cur)) return;
    f32x4 acc[2][2][4][2];
#pragma unroll
    for (int a = 0; a < 2; ++a)
#pragma unroll
        for (int b = 0; b < 2; ++b)
#pragma unroll
            for (int m = 0; m < 4; ++m)
#pragma unroll
                for (int n = 0; n < 2; ++n) acc[a][b][m][n] = (f32x4){0.f, 0.f, 0.f, 0.f};
    bf16x8 At[4][2], B0[2][2], B1[2][2];
    const char* cA = (const char*)g.A + (size_t)cur.pm * tstep; const char* cB = (const char*)g.Bt + (size_t)cur.pn * tstep;
    S.a_ready(cur);
    if constexpr (SP2) {
        PG8_STAGE(PG8_SB(0, 0), cB, voffB); PG8_STAGE(PG8_SB(0, 1), cB + hstep, voffB); PG8_STAGE(PG8_SA(0, 0), cA, voffA); PG8_STAGE(PG8_SA(0, 1), cA + hstep, voffA);
        if (wr == 1) PG8_BAR;
        PG8_WAIT_V(2); PG8_BAR;
        PG8_STAGE(PG8_SB(1, 0), cB + kstep, voffB); PG8_STAGE(PG8_SA(1, 0), cA + kstep, voffA); PG8_STAGE(PG8_SB(1, 1), cB + hstep + kstep, voffB);
        PG8_WAIT_V(6); PG8_BAR;
    } else {
        PG8_STAGE(PG8_SB(0, 0), cB, voffB); PG8_STAGE(PG8_SA(0, 0), cA, voffA); PG8_STAGE(PG8_SB(0, 1), cB + hstep, voffB); PG8_STAGE(PG8_SA(0, 1), cA + hstep, voffA);
        if (wr == 1) PG8_BAR;
        PG8_WAIT_V(4); PG8_BAR;
        PG8_STAGE(PG8_SB(1, 0), cB + kstep, voffB); PG8_STAGE(PG8_SA(1, 0), cA + kstep, voffA); PG8_STAGE(PG8_SB(1, 1), cB + hstep + kstep, voffB);
        PG8_WAIT_V(6); PG8_BAR;
    }
    for (;;) {
        const bool has_next = S.next(ui + 1, nxt);
        const char* nA = has_next ? (const char*)g.A + (size_t)nxt.pm * tstep : cA; const char* nB = has_next ? (const char*)g.Bt + (size_t)nxt.pn * tstep : cB;
        for (int t = 0; t < nt; t += 2) {
            const bool last = (t == nt - 2);
            const char* a1 = cA + (size_t)(t + 1) * kstep;
            const char* a2 = last ? nA : cA + (size_t)(t + 2) * kstep; const char* b2 = last ? nB : cB + (size_t)(t + 2) * kstep;
            const char* a3 = a2 + kstep; const char* b3 = b2 + kstep;
            if (last && has_next) S.a_ready(nxt);
            if constexpr (SP2) {
            PG8_LDB(B0, 0, 0); PG8_LDB(B1, 0, 1); PG8_SCHED; PG8_LDA(At, 0, 0); PG8_STAGE(PG8_SA(1, 1), a1 + hstep, voffA);
            PG8_WAIT_V(8); PG8_WAIT_L(0); PG8_BAR; PG8_MMA(0, 0, At, B0); PG8_MMA(0, 1, At, B1); PG8_BAR; PG8_SCHED;
            PG8_LDA(At, 0, 1); PG8_STAGE(PG8_SB(0, 0), b2, voffB); PG8_STAGE(PG8_SB(0, 1), b2 + hstep, voffB); PG8_STAGE(PG8_SA(0, 0), a2, voffA);
            PG8_WAIT_V(8); PG8_WAIT_L(0); PG8_BAR; PG8_MMA(1, 0, At, B0); PG8_MMA(1, 1, At, B1); PG8_BAR; PG8_SCHED;
            PG8_LDB(B0, 1, 0); PG8_LDB(B1, 1, 1); PG8_SCHED; PG8_LDA(At, 1, 0); PG8_STAGE(PG8_SA(0, 1), a2 + hstep, voffA);
            PG8_WAIT_V(8); PG8_WAIT_L(0); PG8_BAR; PG8_MMA(0, 0, At, B0); PG8_MMA(0, 1, At, B1); PG8_BAR; PG8_SCHED;
            PG8_LDA(At, 1, 1); PG8_STAGE(PG8_SB(1, 0), b3, voffB); PG8_STAGE(PG8_SB(1, 1), b3 + hstep, voffB); PG8_STAGE(PG8_SA(1, 0), a3, voffA);
            PG8_WAIT_V(8); PG8_WAIT_L(0); PG8_BAR; PG8_MMA(1, 0, At, B0); PG8_MMA(1, 1, At, B1); PG8_BAR; PG8_SCHED;
            } else {
            PG8_LDB(B0, 0, 0); PG8_SCHED; PG8_LDA(At, 0, 0); PG8_STAGE(PG8_SA(1, 1), a1 + hstep, voffA);
            PG8_WAIT_L(8); PG8_BAR; PG8_WAIT_L(0); PG8_MMA(0, 0, At, B0); PG8_BAR; PG8_SCHED;
            PG8_LDB(B1, 0, 1); PG8_STAGE(PG8_SB(0, 0), b2, voffB);
            PG8_BAR; PG8_WAIT_L(0); PG8_MMA(0, 1, At, B1); PG8_BAR;
            PG8_LDA(At, 0, 1); PG8_STAGE(PG8_SA(0, 0), a2, voffA);
            PG8_BAR; PG8_WAIT_L(0); PG8_MMA(1, 0, At, B0); PG8_BAR; PG8_SCHED;
            PG8_STAGE(PG8_SB(0, 1), b2 + hstep, voffB);
            PG8_WAIT_V(6); PG8_BAR; PG8_MMA(1, 1, At, B1); PG8_BAR;
            PG8_LDB(B0, 1, 0); PG8_SCHED; PG8_LDA(At, 1, 0); PG8_STAGE(PG8_SA(0, 1), a2 + hstep, voffA);
            PG8_WAIT_L(8); PG8_BAR; PG8_WAIT_L(0); PG8_MMA(0, 0, At, B0); PG8_BAR; PG8_SCHED;
            PG8_LDB(B1, 1, 1); PG8_STAGE(PG8_SB(1, 0), b3, voffB);
            PG8_BAR; PG8_WAIT_L(0); PG8_MMA(0, 1, At, B1); PG8_BAR;
            PG8_LDA(At, 1, 1); PG8_STAGE(PG8_SA(1, 0), a3, voffA);
            PG8_BAR; PG8_WAIT_L(0); PG8_MMA(1, 0, At, B0); PG8_BAR; PG8_SCHED;
            PG8_STAGE(PG8_SB(1, 1), b3 + hstep, voffB);
            PG8_WAIT_V(6); PG8_BAR; PG8_MMA(1, 1, At, B1); PG8_BAR;
            }
        }
        if constexpr (ALIGN_EPI) { if (wr == 0) PG8_BAR; }
        if constexpr (!Epi::AFTER_DRAIN) { E(acc, cur, wr, wc, fr, fq); S.done(cur); }
        if (!has_next) break;
#pragma unroll
        for (int a = 0; a < 2; ++a)
#pragma unroll
            for (int b = 0; b < 2; ++b)
#pragma unroll
                for (int m = 0; m < 4; ++m)
#pragma unroll
                    for (int n = 0; n < 2; ++n) acc[a][b][m][n] = (f32x4){0.f, 0.f, 0.f, 0.f};
        cur = nxt; cA = nA; cB = nB; ++ui;
        if constexpr (ALIGN_EPI) { if (wr == 1) PG8_BAR; }
    }
    PG8_WAIT_V(0);
    if constexpr (!ALIGN_EPI) { if (wr == 0) PG8_BAR; }
    PG8_BAR;
    if constexpr (Epi::AFTER_DRAIN) { E.fused(acc, cur, wr, wc, fr, fq, lds, wid, lane); S.done(cur); }
#undef PG8_SA
#undef PG8_SB
#undef PG8_STAGE
#undef PG8_LDA
#undef PG8_LDB
#undef PG8_MMA
#undef PG8_WAIT_V
#undef PG8_WAIT_L
#undef PG8_BAR
#undef PG8_SCHED
}
}

constexpr int DM = 1024, TP = 2048, TS = 8192, MP = 8 * TP, MS = 8 * TS, M = MP + MS;
constexpr int INW = 6144, DFF = 4096;
constexpr size_t MiB = 1u << 20;
constexpr size_t WS_CTL = 0, WS_ROPE = 1 * MiB, WS_PART = 2 * MiB, WS_W = 8 * MiB, WS_XN = 40 * MiB, WS_OHF = 40 * MiB, WS_OHB = 120 * MiB;
constexpr size_t WS_Q = 200 * MiB, WS_K = 280 * MiB, WS_V = 360 * MiB, WS_QH = 440 * MiB, WS_I = 520 * MiB, WS_G = 600 * MiB, WS_F = 680 * MiB;
constexpr size_t WS_MB = 280 * MiB, WS_HID = 200 * MiB, WS_END = 1000 * MiB;
constexpr size_t W_IN = 0, W_HG = (size_t)INW * DM, W_DA = W_HG + 512 * 1024, W_OUT = W_DA + 512 * 1024, W_M1 = W_OUT + 1024 * 1024, W_M2 = W_M1 + (size_t)DFF * DM;
constexpr int LDS_BYTES = 147456;
constexpr float LOG2E = 1.4426950408889634f;
constexpr float C2 = 0.125f * LOG2E;
constexpr float HG_SCALE = 0.08838834764831845f;

#define LAS __attribute__((address_space(3)))
typedef unsigned short bf16_t;
typedef short bf16x8 __attribute__((ext_vector_type(8)));
typedef short s16x4 __attribute__((ext_vector_type(4)));
typedef float f32x4 __attribute__((ext_vector_type(4)));
typedef float f32x16 __attribute__((ext_vector_type(16)));
typedef unsigned u32x4 __attribute__((ext_vector_type(4)));
typedef unsigned u32x2 __attribute__((ext_vector_type(2)));

__device__ __forceinline__ unsigned cvtpk(float lo, float hi) { return pg8::cvt_pk_bf16(lo, hi); }
__device__ __forceinline__ float bf2f(unsigned short b) { return __uint_as_float((unsigned)b << 16); }
__device__ __forceinline__ float bflo(unsigned w) { return __uint_as_float(w << 16); }
__device__ __forceinline__ float bfhi(unsigned w) { return __uint_as_float(w & 0xffff0000u); }
__device__ __forceinline__ float ex2(float x) { return __builtin_amdgcn_exp2f(x); }
__device__ __forceinline__ float sigm(float v) { return __builtin_amdgcn_rcpf(1.f + ex2(-v * LOG2E)); }
__device__ __forceinline__ int crow(int i, int h) { return (i & 3) + 8 * (i >> 2) + 4 * h; }
__device__ __forceinline__ float swap_max(float m) { auto rr = __builtin_amdgcn_permlane32_swap(__float_as_uint(m), __float_as_uint(m), false, false); return fmaxf(__uint_as_float(rr[0]), __uint_as_float(rr[1])); }
__device__ __forceinline__ float swap_sum(float m) { auto rr = __builtin_amdgcn_permlane32_swap(__float_as_uint(m), __float_as_uint(m), false, false); return __uint_as_float(rr[0]) + __uint_as_float(rr[1]); }
#define MFMA32(a, b, c) __builtin_amdgcn_mfma_f32_32x32x16_bf16((a), (b), (c), 0, 0, 0)

namespace epi {
using pg8::Unit; using pg8::f32x4;
__device__ __forceinline__ void st8(bf16_t* p, f32x4 a, f32x4 b) { u32x4 w; w.x = cvtpk(a[0], a[1]); w.y = cvtpk(a[2], a[3]); w.z = cvtpk(b[0], b[1]); w.w = cvtpk(b[2], b[3]); *(u32x4*)p = w; }

struct EpiIn {
    static constexpr bool PERM = true, AFTER_DRAIN = false;
    bf16_t *Q, *K, *V, *QH, *I, *G, *GATES; float* F; const float* lbl; const float* rope;
    __device__ __forceinline__ void operator()(const f32x4 (&acc)[2][2][4][2], const Unit& u, int wr, int wc, int fr, int fq) const {
        const int pn = u.pn, row0 = u.pm * 256 + wr * 64 + fr, cw = wc * 32 + 8 * fq;
        if (pn >= 16) {
            const int col0 = (pn - 16) * 256 + cw;
#pragma unroll
            for (int ai = 0; ai < 2; ++ai)
#pragma unroll
                for (int m = 0; m < 4; ++m) { bf16_t* rp = GATES + (size_t)(row0 + ai * 128 + m * 16) * 2048 + col0;
#pragma unroll
                    for (int bj = 0; bj < 2; ++bj) { f32x4 a = acc[ai][bj][m][0], b = acc[ai][bj][m][1];
#pragma unroll
                        for (int e = 0; e < 4; ++e) { a[e] = sigm(a[e]); b[e] = sigm(b[e]); }
                        st8(rp + bj * 128, a, b); } }
            return;
        }
        const int sec = pn >> 1, col0 = (pn & 1) * 256 + cw;
        if (sec == 4 || sec == 5) {
            const int d = sec - 4;
            f32x4 lb[2][2];
#pragma unroll
            for (int bj = 0; bj < 2; ++bj)
#pragma unroll
                for (int n = 0; n < 2; ++n) { const f32x4 l0 = *(const f32x4*)(lbl + d * 1024 + col0 + bj * 128 + 4 * n), l1 = *(const f32x4*)(lbl + d * 1024 + 512 + col0 + bj * 128 + 4 * n);
#pragma unroll
                    for (int e = 0; e < 4; ++e) lb[bj][n][e] = sigm(l0[e] - l1[e]); }
#pragma unroll
            for (int ai = 0; ai < 2; ++ai)
#pragma unroll
                for (int m = 0; m < 4; ++m) { float* rp = F + (size_t)(row0 + ai * 128 + m * 16) * 1024 + d * 512 + col0;
#pragma unroll
                    for (int bj = 0; bj < 2; ++bj)
#pragma unroll
                        for (int n = 0; n < 2; ++n) { f32x4 a = acc[ai][bj][m][n];
#pragma unroll
                            for (int e = 0; e < 4; ++e) a[e] = lb[bj][n][e] + (1.f - lb[bj][n][e]) * sigm(a[e]);
                            *(f32x4*)(rp + bj * 128 + 4 * n) = a; } }
            return;
        }
        bf16_t* base = sec == 0 ? Q : sec == 1 ? K : sec == 2 ? V : sec == 3 ? QH : sec == 6 ? I : G;
        const bool rot = (sec < 2) && ((wc & 1) == 0);
#pragma unroll
        for (int ai = 0; ai < 2; ++ai)
#pragma unroll
            for (int m = 0; m < 4; ++m) { const int row = row0 + ai * 128 + m * 16; bf16_t* rp = base + (size_t)row * 512 + col0;
                f32x4 cs[4];
                if (rot) { const int pos = row < MP ? (row & (TP - 1)) : ((row - MP) & (TS - 1)); const f32x4* rt = (const f32x4*)(rope + (size_t)pos * 16);
#pragma unroll
                    for (int k = 0; k < 4; ++k) cs[k] = rt[k]; }
#pragma unroll
                for (int bj = 0; bj < 2; ++bj) { f32x4 a = acc[ai][bj][m][0], b = acc[ai][bj][m][1];
                    if (sec < 2) {
                        if (rot) {
#pragma unroll
                            for (int e = 0; e < 4; ++e) { const float pa = __shfl_xor(a[e], 16), pb = __shfl_xor(b[e], 16);
                                const float ca = cs[e >> 1][(e & 1) * 2], sa = cs[e >> 1][(e & 1) * 2 + 1], cb = cs[2 + (e >> 1)][(e & 1) * 2], sb = cs[2 + (e >> 1)][(e & 1) * 2 + 1];
                                if (fq == 0) { a[e] = a[e] * ca - pa * sa; b[e] = b[e] * cb - pb * sb; }
                                else if (fq == 1) { a[e] = a[e] * ca + pa * sa; b[e] = b[e] * cb + pb * sb; } }
                        }
                        if (sec == 0) { a = a * C2; b = b * C2; }
                    } else if (sec == 3) {
#pragma unroll
                        for (int e = 0; e < 4; ++e) { a[e] = a[e] * sigm(a[e]) * HG_SCALE; b[e] = b[e] * sigm(b[e]) * HG_SCALE; }
                    } else if (sec == 7) {
#pragma unroll
                        for (int e = 0; e < 4; ++e) { a[e] = a[e] * sigm(a[e]); b[e] = b[e] * sigm(b[e]); }
                    }
                    st8(rp + bj * 128, a, b); } }
    }
};

template <int MODE> struct EpiGate {
    static constexpr bool PERM = true, AFTER_DRAIN = false;
    const bf16_t* GATES; bf16_t* MB;
    __device__ __forceinline__ void operator()(const f32x4 (&acc)[2][2][4][2], const Unit& u, int wr, int wc, int fr, int fq) const {
        const int row0 = u.pm * 256 + wr * 64 + fr, col0 = u.pn * 256 + wc * 32 + 8 * fq;
#pragma unroll
        for (int ai = 0; ai < 2; ++ai)
#pragma unroll
            for (int m = 0; m < 4; ++m) { const int row = row0 + ai * 128 + m * 16;
#pragma unroll
                for (int bj = 0; bj < 2; ++bj) { const int col = col0 + bj * 128;
                    const u32x4 g = *(const u32x4*)(GATES + (size_t)row * 2048 + MODE * 1024 + col);
                    f32x4 a = acc[ai][bj][m][0], b = acc[ai][bj][m][1];
                    a[0] *= bflo(g.x); a[1] *= bfhi(g.x); a[2] *= bflo(g.y); a[3] *= bfhi(g.y); b[0] *= bflo(g.z); b[1] *= bfhi(g.z); b[2] *= bflo(g.w); b[3] *= bfhi(g.w);
                    bf16_t* mp = MB + (size_t)row * 1024 + col;
                    if (MODE == 1) { const u32x4 p = *(const u32x4*)mp;
                        a[0] += bflo(p.x); a[1] += bfhi(p.x); a[2] += bflo(p.y); a[3] += bfhi(p.y); b[0] += bflo(p.z); b[1] += bfhi(p.z); b[2] += bflo(p.w); b[3] += bfhi(p.w); }
                    st8(mp, a, b); } }
    }
};

template <bool WITH_XB> struct EpiRes {
    static constexpr bool PERM = true, AFTER_DRAIN = false;
    const float* xp; const float* xs; float* OUT; bf16_t* XB; float* PART;
    __device__ __forceinline__ void operator()(const f32x4 (&acc)[2][2][4][2], const Unit& u, int wr, int wc, int fr, int fq) const {
        const int row0 = u.pm * 256 + wr * 64 + fr, col0 = u.pn * 256 + wc * 32 + 8 * fq;
#pragma unroll
        for (int ai = 0; ai < 2; ++ai)
#pragma unroll
            for (int m = 0; m < 4; ++m) { const int row = row0 + ai * 128 + m * 16; float ss = 0.f;
                const float* bp = xp ? (row < MP ? xp + (size_t)row * 1024 : xs + (size_t)(row - MP) * 1024) : OUT + (size_t)row * 1024;
#pragma unroll
                for (int bj = 0; bj < 2; ++bj) { const int col = col0 + bj * 128;
                    f32x4 a = acc[ai][bj][m][0] + *(const f32x4*)(bp + col), b = acc[ai][bj][m][1] + *(const f32x4*)(bp + col + 4);
                    *(f32x4*)(OUT + (size_t)row * 1024 + col) = a; *(f32x4*)(OUT + (size_t)row * 1024 + col + 4) = b;
                    if (WITH_XB) st8(XB + (size_t)row * 1024 + col, a, b);
                    ss += (a[0] * a[0] + a[1] * a[1]) + (a[2] * a[2] + a[3] * a[3]) + (b[0] * b[0] + b[1] * b[1]) + (b[2] * b[2] + b[3] * b[3]); }
                ss += __shfl_xor(ss, 16); ss += __shfl_xor(ss, 32);
                if (fq == 0) PART[(size_t)row * 16 + u.pn * 4 + wc] = ss; }
    }
};

struct EpiMlpIn {
    static constexpr bool PERM = true, AFTER_DRAIN = false;
    const float* PART; bf16_t* HID;
    __device__ __forceinline__ void operator()(const f32x4 (&acc)[2][2][4][2], const Unit& u, int wr, int wc, int fr, int fq) const {
        const int row0 = u.pm * 256 + wr * 64 + fr, col0 = u.pn * 256 + wc * 32 + 8 * fq;
#pragma unroll
        for (int ai = 0; ai < 2; ++ai)
#pragma unroll
            for (int m = 0; m < 4; ++m) { const int row = row0 + ai * 128 + m * 16;
                const f32x4* pp = (const f32x4*)(PART + (size_t)row * 16); const f32x4 p0 = pp[0], p1 = pp[1], p2 = pp[2], p3 = pp[3];
                const float s = ((p0[0] + p0[1]) + (p0[2] + p0[3])) + ((p1[0] + p1[1]) + (p1[2] + p1[3])) + ((p2[0] + p2[1]) + (p2[2] + p2[3])) + ((p3[0] + p3[1]) + (p3[2] + p3[3]));
                const float r2 = 1.f / (s * (1.f / 1024.f) + 1e-6f);
#pragma unroll
                for (int bj = 0; bj < 2; ++bj) { f32x4 a = acc[ai][bj][m][0], b = acc[ai][bj][m][1];
#pragma unroll
                    for (int e = 0; e < 4; ++e) { const float x = fmaxf(a[e], 0.f), y = fmaxf(b[e], 0.f); a[e] = x * x * r2; b[e] = y * y * r2; }
                    st8(HID + (size_t)row * DFF + col0 + bj * 128, a, b); } }
    }
};
}

__device__ __forceinline__ float wave_sum(float v) {
#pragma unroll
    for (int o = 1; o < 64; o <<= 1) v += __shfl_xor(v, o);
    return v;
}
__device__ __forceinline__ void transpose_item(const float* W, int K, int N, bf16_t* WT, const float* sc, LAS float* scr, int item, int lane) {
    const int nblk = N / 32, kb = item / nblk, nb = item % nblk, k0 = 64 * kb, n0 = 32 * nb;
#pragma unroll 8
    for (int i = 0; i < 32; ++i) { const int kk = 2 * i + (lane >> 5); float v = W[(size_t)(k0 + kk) * N + n0 + (lane & 31)]; if (sc) v *= sc[k0 + kk]; scr[kk * 33 + (lane & 31)] = v; }
    asm volatile("s_waitcnt lgkmcnt(0)" ::: "memory");
    const int c = lane & 7;
#pragma unroll
    for (int j = 0; j < 4; ++j) { const int n = (lane >> 3) + 8 * j; const LAS float* s = scr + (8 * c) * 33 + n;
        u32x4 o; o.x = cvtpk(s[0 * 33], s[1 * 33]); o.y = cvtpk(s[2 * 33], s[3 * 33]); o.z = cvtpk(s[4 * 33], s[5 * 33]); o.w = cvtpk(s[6 * 33], s[7 * 33]);
        *(u32x4*)(WT + (size_t)(n0 + n) * K + k0 + 8 * c) = o; }
    asm volatile("s_waitcnt lgkmcnt(0)" ::: "memory");
}

struct Args {
    const float* in[18]; float* out; unsigned char* ws; int grid_expect; int pad;
};

namespace att {
constexpr int KROW = 144, VROW = 320, KTILE = 64 * KROW, KBUF = 2 * KTILE, VBUF = 64 * VROW;
constexpr int OFF_K = 0, OFF_V = 2 * KBUF, OFF_X = OFF_V + 2 * VBUF, OFF_MISC = OFF_X + 65536;
static_assert(OFF_MISC + 64 <= LDS_BYTES, "attention LDS map");
typedef short v4i16_t __attribute__((ext_vector_type(4)));
__device__ __forceinline__ s16x4 vtr(const LAS char* p) { return __builtin_bit_cast(s16x4, __builtin_amdgcn_ds_read_tr16_b64_v4i16((LAS v4i16_t*)p)); }

__device__ __forceinline__ void attn_unit(LAS char* lds, int seqbase, int T, int h, int qb, const bf16_t* Qb, const bf16_t* Kb, const bf16_t* Vb, bf16_t* OA, float lam, const float* subln) {
    int tid_ = threadIdx.x; asm volatile("" : "+v"(tid_));
    const int tid = tid_, lane = tid & 63, r = lane & 31, hh = lane >> 5, w = __builtin_amdgcn_readfirstlane(tid >> 6), comp = w >> 2, qs = w & 3;
    const size_t qrow = (size_t)seqbase + qb * 128 + qs * 32 + r;
    bf16x8 qf[4];
#pragma unroll
    for (int d0 = 0; d0 < 4; ++d0) qf[d0] = *(const bf16x8*)(Qb + qrow * 512 + (2 * h + comp) * 64 + d0 * 16 + hh * 8);
    f32x16 o[4];
#pragma unroll
    for (int vt = 0; vt < 4; ++vt)
#pragma unroll
        for (int i = 0; i < 16; ++i) o[vt][i] = 0.f;
    float mrun = -1e30f, lrun = 0.f;
    const int NT = T / 64;
    const bf16_t* ksrc = Kb + ((size_t)seqbase + (tid >> 3)) * 512 + (2 * h) * 64 + (tid & 7) * 8;
    const bf16_t* vsrc = Vb + ((size_t)seqbase + (tid >> 4)) * 512 + h * 128 + (tid & 15) * 8;
    const int kdst = OFF_K + (tid >> 3) * KROW + (tid & 7) * 16, vdst = OFF_V + (tid >> 4) * VROW + (tid & 15) * 16;
    u32x4 kr0, kr1, vr0, vr1;
    kr0 = *(const u32x4*)(ksrc); kr1 = *(const u32x4*)(ksrc + 64); vr0 = *(const u32x4*)(vsrc); vr1 = *(const u32x4*)(vsrc + 32 * 512);
    *(LAS u32x4*)(lds + kdst) = kr0; *(LAS u32x4*)(lds + kdst + KTILE) = kr1; *(LAS u32x4*)(lds + vdst) = vr0; *(LAS u32x4*)(lds + vdst + 32 * VROW) = vr1;
    __syncthreads();
    const int i16 = lane & 15, q4 = i16 >> 2, p4 = i16 & 3, blk = (lane >> 4) & 1;
    const int vlane = (4 * hh + q4) * VROW + (16 * blk + 4 * p4) * 2;
    const int klane = comp * KTILE + r * KROW + hh * 16;
    for (int t = 0; t < NT; ++t) {
        const int buf = t & 1;
        if (t + 1 < NT) { const size_t adv = (size_t)(t + 1) * 64 * 512;
            kr0 = *(const u32x4*)(ksrc + adv); kr1 = *(const u32x4*)(ksrc + adv + 64); vr0 = *(const u32x4*)(vsrc + adv); vr1 = *(const u32x4*)(vsrc + adv + 32 * 512); }
        f32x16 s0, s1;
#pragma unroll
        for (int i = 0; i < 16; ++i) { s0[i] = 0.f; s1[i] = 0.f; }
        const LAS char* kb = lds + OFF_K + buf * KBUF + klane;
#pragma unroll
        for (int d0 = 0; d0 < 4; ++d0) {
            const bf16x8 a0 = *(const LAS bf16x8*)(kb + d0 * 32), a1 = *(const LAS bf16x8*)(kb + 32 * KROW + d0 * 32);
            s0 = MFMA32(a0, qf[d0], s0); s1 = MFMA32(a1, qf[d0], s1);
        }
        float mx = fmaxf(s0[0], s1[0]);
#pragma unroll
        for (int i = 1; i < 16; ++i) mx = fmaxf(mx, fmaxf(s0[i], s1[i]));
        mx = swap_max(mx);
        const float mnew = fmaxf(mrun, mx);
        if (__any(mnew > mrun)) {
            const float alpha = ex2(mrun - mnew);
            lrun *= alpha;
#pragma unroll
            for (int vt = 0; vt < 4; ++vt)
#pragma unroll
                for (int i = 0; i < 16; ++i) o[vt][i] *= alpha;
            mrun = mnew;
        }
        float ls = 0.f;
#pragma unroll
        for (int i = 0; i < 16; ++i) { s0[i] = ex2(s0[i] - mrun); s1[i] = ex2(s1[i] - mrun); ls += s0[i] + s1[i]; }
        lrun += ls;
        bf16x8 pf[4];
#pragma unroll
        for (int s = 0; s < 2; ++s) {
            u32x4 a, b;
            a.x = cvtpk(s0[8 * s + 0], s0[8 * s + 1]); a.y = cvtpk(s0[8 * s + 2], s0[8 * s + 3]); a.z = cvtpk(s0[8 * s + 4], s0[8 * s + 5]); a.w = cvtpk(s0[8 * s + 6], s0[8 * s + 7]);
            b.x = cvtpk(s1[8 * s + 0], s1[8 * s + 1]); b.y = cvtpk(s1[8 * s + 2], s1[8 * s + 3]); b.z = cvtpk(s1[8 * s + 4], s1[8 * s + 5]); b.w = cvtpk(s1[8 * s + 6], s1[8 * s + 7]);
            pf[s] = __builtin_bit_cast(bf16x8, a); pf[2 + s] = __builtin_bit_cast(bf16x8, b);
        }
        const LAS char* vb = lds + OFF_V + buf * VBUF + vlane;
#pragma unroll
        for (int ks = 0; ks < 4; ++ks) {
#pragma unroll
            for (int vt = 0; vt < 4; ++vt) {
                const s16x4 lo = vtr(vb + (16 * ks) * VROW + vt * 64), hi = vtr(vb + (16 * ks + 8) * VROW + vt * 64);
                const bf16x8 vf = __builtin_shufflevector(lo, hi, 0, 1, 2, 3, 4, 5, 6, 7);
                o[vt] = MFMA32(vf, pf[ks], o[vt]);
            }
        }
        if (t + 1 < NT) { const int nb = buf ^ 1;
            *(LAS u32x4*)(lds + kdst + nb * KBUF) = kr0; *(LAS u32x4*)(lds + kdst + nb * KBUF + KTILE) = kr1;
            *(LAS u32x4*)(lds + vdst + nb * VBUF) = vr0; *(LAS u32x4*)(lds + vdst + nb * VBUF + 32 * VROW) = vr1; }
        __syncthreads();
    }
    lrun = swap_sum(lrun);
    const float inv = 1.f / lrun;
    LAS float* X = (LAS float*)(lds + OFF_X) + qs * 4096 + lane;
    if (comp == 1) {
        const float sc = inv * lam;
#pragma unroll
        for (int vt = 0; vt < 4; ++vt)
#pragma unroll
            for (int i = 0; i < 16; ++i) X[(vt * 16 + i) * 64] = o[vt][i] * sc;
    }
    __syncthreads();
    if (comp == 0) {
        float ss = 0.f;
#pragma unroll
        for (int vt = 0; vt < 4; ++vt)
#pragma unroll
            for (int i = 0; i < 16; ++i) { const float d = o[vt][i] * inv - X[(vt * 16 + i) * 64]; o[vt][i] = d; ss += d * d; }
        ss = swap_sum(ss);
        const float rs = 0.8f / sqrtf(ss * (1.f / 128.f) + 1e-5f);
        bf16_t* op = OA + qrow * 512 + h * 128;
#pragma unroll
        for (int vt = 0; vt < 4; ++vt)
#pragma unroll
            for (int g = 0; g < 4; ++g) { const int v = 32 * vt + 8 * g + 4 * hh; const f32x4 sw = *(const f32x4*)(subln + v);
                u32x2 wv; wv.x = cvtpk(o[vt][4 * g] * rs * sw[0], o[vt][4 * g + 1] * rs * sw[1]); wv.y = cvtpk(o[vt][4 * g + 2] * rs * sw[2], o[vt][4 * g + 3] * rs * sw[3]);
                *(u32x2*)(op + v) = wv; }
    }
    __syncthreads();
}
}

namespace gla {
constexpr int QROW = 272, SROW = 144;
constexpr int OFF_QT = 0, OFF_KT = 17408, OFF_KTT = 34816, OFF_VT = 53248, OFF_ST = 62464, OFF_AM = 79872, OFF_TOT = 89088, OFF_GM = 91136, OFF_GL = 91648;
__device__ __forceinline__ void gla_unit(LAS char* lds, int seqbase, int T, int hd, int dir, int vh, const float* F, const bf16_t* QH, const bf16_t* I, bf16_t* OH) {
    int tid_ = threadIdx.x; asm volatile("" : "+v"(tid_));
    const int tid = tid_, lane = tid & 63, r = lane & 31, hh = lane >> 5, w = __builtin_amdgcn_readfirstlane(tid >> 6);
    const int c = tid & 127, seg = tid >> 7, vc = tid & 63, vseg = tid >> 6;
    const int kt = w >> 1, vt = w & 1;
    f32x16 S;
#pragma unroll
    for (int i = 0; i < 16; ++i) S[i] = 0.f;
    LAS float* TOT = (LAS float*)(lds + OFF_TOT); LAS float* GM = (LAS float*)(lds + OFF_GM); LAS float* GL = (LAS float*)(lds + OFF_GL);
    const int NC = T / 64;
    for (int n = 0; n < NC; ++n) {
        float g[16], qv[16], kv[16]; float run = 0.f;
#pragma unroll
        for (int j = 0; j < 16; ++j) { const int t = 64 * n + 16 * seg + j; const size_t row = (size_t)seqbase + (dir ? T - 1 - t : t);
            const float f = F[row * 1024 + dir * 512 + hd * 128 + c]; qv[j] = bf2f(QH[row * 512 + hd * 128 + c]);
            run += __builtin_amdgcn_logf(f); g[j] = run; kv[j] = 1.f - f; }
        unsigned short vv[8];
#pragma unroll
        for (int j = 0; j < 8; ++j) { const int t = 64 * n + 8 * vseg + j; const size_t row = (size_t)seqbase + (dir ? T - 1 - t : t); vv[j] = I[row * 512 + hd * 128 + vh * 64 + vc]; }
        TOT[seg * 128 + c] = run;
        __syncthreads();
        const float t0 = TOT[c], t1 = TOT[128 + c], t2 = TOT[256 + c], t3 = TOT[384 + c];
        const float gbase = (seg > 0 ? t0 : 0.f) + (seg > 1 ? t1 : 0.f) + (seg > 2 ? t2 : 0.f);
        const float gmid = t0 + t1, glast = (t0 + t1) + (t2 + t3);
        unsigned kp[8];
#pragma unroll
        for (int j = 0; j < 16; j += 2) {
            const float ga = g[j] + gbase - gmid, gb = g[j + 1] + gbase - gmid;
            const float qa = qv[j] * ex2(ga), qb = qv[j + 1] * ex2(gb), ka = kv[j] * ex2(-ga), kb2 = kv[j + 1] * ex2(-gb);
            const unsigned qw = cvtpk(qa, qb), kw = cvtpk(ka, kb2);
            *(LAS unsigned short*)(lds + OFF_QT + (16 * seg + j) * QROW + c * 2) = (unsigned short)(qw & 0xffffu);
            *(LAS unsigned short*)(lds + OFF_QT + (16 * seg + j + 1) * QROW + c * 2) = (unsigned short)(qw >> 16);
            *(LAS unsigned short*)(lds + OFF_KT + (16 * seg + j) * QROW + c * 2) = (unsigned short)(kw & 0xffffu);
            *(LAS unsigned short*)(lds + OFF_KT + (16 * seg + j + 1) * QROW + c * 2) = (unsigned short)(kw >> 16);
            kp[j >> 1] = kw;
        }
        *(LAS u32x4*)(lds + OFF_KTT + c * SROW + seg * 32) = (u32x4){kp[0], kp[1], kp[2], kp[3]};
        *(LAS u32x4*)(lds + OFF_KTT + c * SROW + seg * 32 + 16) = (u32x4){kp[4], kp[5], kp[6], kp[7]};
        *(LAS u32x4*)(lds + OFF_VT + vc * SROW + vseg * 16) = (u32x4){(unsigned)vv[0] | ((unsigned)vv[1] << 16), (unsigned)vv[2] | ((unsigned)vv[3] << 16), (unsigned)vv[4] | ((unsigned)vv[5] << 16), (unsigned)vv[6] | ((unsigned)vv[7] << 16)};
        if (seg == 0) { GM[c] = gmid; GL[c] = glast; }
        __syncthreads();
#pragma unroll
        for (int gq = 0; gq < 4; ++gq) { const int k = 32 * kt + 8 * gq + 4 * hh; const f32x4 gm = *(const LAS f32x4*)(GM + k);
            u32x2 wv; wv.x = cvtpk(S[4 * gq] * ex2(gm[0]), S[4 * gq + 1] * ex2(gm[1])); wv.y = cvtpk(S[4 * gq + 2] * ex2(gm[2]), S[4 * gq + 3] * ex2(gm[3]));
            *(LAS u32x2*)(lds + OFF_ST + (32 * vt + r) * QROW + k * 2) = wv; }
        if (w < 4) {
            const int st = w >> 1, tt = w & 1; f32x16 a;
#pragma unroll
            for (int i = 0; i < 16; ++i) a[i] = 0.f;
#pragma unroll
            for (int ks = 0; ks < 8; ++ks) {
                const bf16x8 af = *(const LAS bf16x8*)(lds + OFF_KT + (32 * st + r) * QROW + (16 * ks + 8 * hh) * 2), bfr = *(const LAS bf16x8*)(lds + OFF_QT + (32 * tt + r) * QROW + (16 * ks + 8 * hh) * 2);
                a = MFMA32(af, bfr, a);
            }
            const int tq = 32 * tt + r;
#pragma unroll
            for (int gq = 0; gq < 4; ++gq) { const int s = 32 * st + 8 * gq + 4 * hh;
                const float a0 = (s + 0 <= tq) ? a[4 * gq] : 0.f, a1 = (s + 1 <= tq) ? a[4 * gq + 1] : 0.f, a2 = (s + 2 <= tq) ? a[4 * gq + 2] : 0.f, a3 = (s + 3 <= tq) ? a[4 * gq + 3] : 0.f;
                u32x2 wv; wv.x = cvtpk(a0, a1); wv.y = cvtpk(a2, a3);
                *(LAS u32x2*)(lds + OFF_AM + tq * SROW + s * 2) = wv; }
        }
        __syncthreads();
        if (w < 4) {
            const int tt = w >> 1, v2 = w & 1; f32x16 oo;
#pragma unroll
            for (int i = 0; i < 16; ++i) oo[i] = 0.f;
#pragma unroll
            for (int ks = 0; ks < 8; ++ks) {
                const bf16x8 af = *(const LAS bf16x8*)(lds + OFF_QT + (32 * tt + r) * QROW + (16 * ks + 8 * hh) * 2), bfr = *(const LAS bf16x8*)(lds + OFF_ST + (32 * v2 + r) * QROW + (16 * ks + 8 * hh) * 2);
                oo = MFMA32(af, bfr, oo);
            }
#pragma unroll
            for (int ks = 0; ks < 4; ++ks) {
                const bf16x8 af = *(const LAS bf16x8*)(lds + OFF_AM + (32 * tt + r) * SROW + (16 * ks + 8 * hh) * 2), bfr = *(const LAS bf16x8*)(lds + OFF_VT + (32 * v2 + r) * SROW + (16 * ks + 8 * hh) * 2);
                oo = MFMA32(af, bfr, oo);
            }
#pragma unroll
            for (int i = 0; i < 16; ++i) { const int t = 64 * n + 32 * tt + crow(i, hh); const size_t row = (size_t)seqbase + (dir ? T - 1 - t : t);
                OH[row * 512 + hd * 128 + vh * 64 + 32 * v2 + r] = (unsigned short)(cvtpk(oo[i], 0.f) & 0xffffu); }
        }
        {
            f32x16 ds;
#pragma unroll
            for (int i = 0; i < 16; ++i) ds[i] = 0.f;
#pragma unroll
            for (int ks = 0; ks < 4; ++ks) {
                const bf16x8 af = *(const LAS bf16x8*)(lds + OFF_KTT + (32 * kt + r) * SROW + (16 * ks + 8 * hh) * 2), bfr = *(const LAS bf16x8*)(lds + OFF_VT + (32 * vt + r) * SROW + (16 * ks + 8 * hh) * 2);
                ds = MFMA32(af, bfr, ds);
            }
#pragma unroll
            for (int gq = 0; gq < 4; ++gq) { const int k = 32 * kt + 8 * gq + 4 * hh; const f32x4 gl = *(const LAS f32x4*)(GL + k), gm = *(const LAS f32x4*)(GM + k);
#pragma unroll
                for (int e = 0; e < 4; ++e) S[4 * gq + e] = S[4 * gq + e] * ex2(gl[e]) + ds[4 * gq + e] * ex2(gl[e] - gm[e]); }
        }
        __syncthreads();
    }
}
}

__global__ void __launch_bounds__(512, 2) fwd_megakernel(Args args) {
    extern __shared__ __attribute__((aligned(16))) unsigned char lds_raw[];
    cg::grid_group grid = cg::this_grid();
    LAS unsigned char* lds = (LAS unsigned char*)lds_raw;
    const int tid = threadIdx.x, lane = tid & 63, wave = __builtin_amdgcn_readfirstlane(tid >> 6);
    const int G = gridDim.x, bx = blockIdx.x;
    unsigned char* ws = args.ws;
    const float* x_p = args.in[0]; const float* x_s = args.in[1]; const float* norm1 = args.in[2]; const float* w_in = args.in[3]; const float* lbl = args.in[4];
    const float* hg_norm = args.in[5]; const float* w_hg = args.in[6]; const float* lq1 = args.in[7]; const float* lk1 = args.in[8]; const float* lq2 = args.in[9]; const float* lk2 = args.in[10];
    const float* subln = args.in[11]; const float* w_da = args.in[12]; const float* w_out = args.in[13]; const float* norm2 = args.in[14]; const float* w_m1 = args.in[15]; const float* w_m2 = args.in[16];
    const float* fnorm = args.in[17];
    float* out = args.out;
    unsigned* ctl = (unsigned*)(ws + WS_CTL); float* rope = (float*)(ws + WS_ROPE); float* PART = (float*)(ws + WS_PART);
    bf16_t* Wb = (bf16_t*)(ws + WS_W); bf16_t* XN = (bf16_t*)(ws + WS_XN); bf16_t* OHF = (bf16_t*)(ws + WS_OHF); bf16_t* OHB = (bf16_t*)(ws + WS_OHB);
    bf16_t* Qb = (bf16_t*)(ws + WS_Q); bf16_t* Kb = (bf16_t*)(ws + WS_K); bf16_t* Vb = (bf16_t*)(ws + WS_V); bf16_t* QH = (bf16_t*)(ws + WS_QH); bf16_t* Ib = (bf16_t*)(ws + WS_I);
    bf16_t* Gb = (bf16_t*)(ws + WS_G); float* Fb = (float*)(ws + WS_F); bf16_t* MB = (bf16_t*)(ws + WS_MB); bf16_t* HID = (bf16_t*)(ws + WS_HID);
    bf16_t* GATES = (bf16_t*)out;
    const int gw = bx * 8 + wave, NGW = G * 8;

    {
        LAS float* scr = (LAS float*)(lds + wave * 8448);
        constexpr int I_IN = 16 * 192, I_HG = 8 * 32, I_DA = 8 * 32, I_OUT = 16 * 32, I_M1 = 16 * 128, I_M2 = 64 * 32;
        constexpr int NITEMS = I_IN + I_HG + I_DA + I_OUT + I_M1 + I_M2;
        for (int it = gw; it < NITEMS; it += NGW) {
            int q = it;
            if (q < I_IN) { transpose_item(w_in, 1024, INW, Wb + W_IN, nullptr, scr, q, lane); continue; } q -= I_IN;
            if (q < I_HG) { transpose_item(w_hg, 512, 1024, Wb + W_HG, nullptr, scr, q, lane); continue; } q -= I_HG;
            if (q < I_DA) { transpose_item(w_da, 512, 1024, Wb + W_DA, nullptr, scr, q, lane); continue; } q -= I_DA;
            if (q < I_OUT) { transpose_item(w_out, 1024, 1024, Wb + W_OUT, nullptr, scr, q, lane); continue; } q -= I_OUT;
            if (q < I_M1) { transpose_item(w_m1, 1024, DFF, Wb + W_M1, norm2, scr, q, lane); continue; } q -= I_M1;
            transpose_item(w_m2, DFF, 1024, Wb + W_M2, nullptr, scr, q, lane);
        }
        for (int m = gw; m < M; m += NGW) {
            const float* xr = m < MP ? x_p + (size_t)m * 1024 : x_s + (size_t)(m - MP) * 1024;
            f32x4 v[4]; float s = 0.f;
#pragma unroll
            for (int j = 0; j < 4; ++j) { v[j] = *(const f32x4*)(xr + 4 * lane + 256 * j); s += (v[j][0] * v[j][0] + v[j][1] * v[j][1]) + (v[j][2] * v[j][2] + v[j][3] * v[j][3]); }
            const float rstd = 1.f / sqrtf(wave_sum(s) * (1.f / 1024.f) + 1e-6f);
#pragma unroll
            for (int j = 0; j < 4; ++j) { const f32x4 gn = *(const f32x4*)(norm1 + 4 * lane + 256 * j);
                u32x2 o; o.x = cvtpk(v[j][0] * rstd * gn[0], v[j][1] * rstd * gn[1]); o.y = cvtpk(v[j][2] * rstd * gn[2], v[j][3] * rstd * gn[3]);
                *(u32x2*)(XN + (size_t)m * 1024 + 4 * lane + 256 * j) = o; }
        }
        for (int e = bx * 512 + tid; e < TS * 8; e += G * 512) { const int pos = e >> 3, j = e & 7;
            const float invf = exp2f(-(float)j * (18.931568569324174f / 8.f));
            const float ang = (float)pos * invf; float sn, cs; sincosf(ang, &sn, &cs);
            rope[(size_t)pos * 16 + 2 * j] = cs; rope[(size_t)pos * 16 + 2 * j + 1] = sn; }
        if (bx == 0 && tid < 64) ctl[tid] = 0u;
    }
    grid.sync();

    {
        pg8::Gemm g{XN, Wb + W_IN, M, INW, 1024}; pg8::StaticOrder S; S.init(M, INW, G, bx);
        epi::EpiIn E{Qb, Kb, Vb, QH, Ib, Gb, GATES, Fb, lbl, rope};
        pg8::gemm_phase<epi::EpiIn, pg8::StaticOrder, true, true>(lds, g, S, E);
    }
    grid.sync();

    {
        for (int u = bx; u < 256; u += G) {
            const int grp = u >> 7, uu = u & 127, seq = uu >> 4, hd = (uu >> 2) & 3, dir = (uu >> 1) & 1, vh = uu & 1;
            const int T = grp == 0 ? TS : TP, seqbase = grp == 0 ? MP + seq * TS : seq * TP;
            gla::gla_unit((LAS char*)lds, seqbase, T, hd, dir, vh, Fb, QH, Ib, dir ? OHB : OHF);
        }
        LAS float* misc = (LAS float*)(lds + att::OFF_MISC);
        if (wave == 0) {
            const float a = wave_sum(lq1[lane] * lk1[lane]), b = wave_sum(lq2[lane] * lk2[lane]);
            if (lane == 0) misc[0] = expf(a) - expf(b) + 0.2f;
        }
        __syncthreads();
        const float lam = misc[0];
        constexpr int NU_S = 8 * 4 * (TS / 128), NU_P = 8 * 4 * (TP / 128), NU = NU_S + NU_P;
        for (;;) {
            __syncthreads();
            if (tid == 0) ((LAS unsigned*)misc)[1] = atomicAdd(ctl, 1u);
            __syncthreads();
            const int u = (int)((LAS unsigned*)misc)[1];
            if (u >= NU) break;
            int seqbase, T, h, qb;
            if (u < NU_S) { const int seq = u / (4 * (TS / 128)), rem = u % (4 * (TS / 128)); h = rem / (TS / 128); qb = rem % (TS / 128); T = TS; seqbase = MP + seq * TS; }
            else { const int v = u - NU_S; const int seq = v / (4 * (TP / 128)), rem = v % (4 * (TP / 128)); h = rem / (TP / 128); qb = rem % (TP / 128); T = TP; seqbase = seq * TP; }
            att::attn_unit((LAS char*)lds, seqbase, T, h, qb, Qb, Kb, Vb, Qb  , lam, subln);
        }
    }
    grid.sync();

    for (int m = gw; m < M; m += NGW) {
        const size_t off = (size_t)m * 512 + 8 * lane;
        const u32x4 a = *(const u32x4*)(OHF + off), b = *(const u32x4*)(OHB + off), gg = *(const u32x4*)(Gb + off);
        float v[8] = {bflo(a.x) + bflo(b.x), bfhi(a.x) + bfhi(b.x), bflo(a.y) + bflo(b.y), bfhi(a.y) + bfhi(b.y), bflo(a.z) + bflo(b.z), bfhi(a.z) + bfhi(b.z), bflo(a.w) + bflo(b.w), bfhi(a.w) + bfhi(b.w)};
        float ss = 0.f;
#pragma unroll
        for (int e = 0; e < 8; ++e) ss += v[e] * v[e];
        ss += __shfl_xor(ss, 1); ss += __shfl_xor(ss, 2); ss += __shfl_xor(ss, 4); ss += __shfl_xor(ss, 8);
        const float rs = 1.f / sqrtf(ss * (1.f / 128.f) + 1e-6f);
        const f32x4 n0 = *(const f32x4*)(hg_norm + 8 * lane), n1 = *(const f32x4*)(hg_norm + 8 * lane + 4);
        const float gv[8] = {bflo(gg.x), bfhi(gg.x), bflo(gg.y), bfhi(gg.y), bflo(gg.z), bfhi(gg.z), bflo(gg.w), bfhi(gg.w)};
        u32x4 o; o.x = cvtpk(v[0] * rs * n0[0] * gv[0], v[1] * rs * n0[1] * gv[1]); o.y = cvtpk(v[2] * rs * n0[2] * gv[2], v[3] * rs * n0[3] * gv[3]);
        o.z = cvtpk(v[4] * rs * n1[0] * gv[4], v[5] * rs * n1[1] * gv[5]); o.w = cvtpk(v[6] * rs * n1[2] * gv[6], v[7] * rs * n1[3] * gv[7]);
        *(u32x4*)(OHF + off) = o;
    }
    grid.sync();

    {
        pg8::StaticOrder S; S.init(M, 1024, G, bx);
        { pg8::Gemm g{OHF, Wb + W_HG, M, 1024, 512}; epi::EpiGate<0> E{GATES, MB}; pg8::gemm_phase<epi::EpiGate<0>, pg8::StaticOrder, true, true>(lds, g, S, E); }
        __syncthreads();
        { pg8::Gemm g{Qb, Wb + W_DA, M, 1024, 512}; epi::EpiGate<1> E{GATES, MB}; pg8::gemm_phase<epi::EpiGate<1>, pg8::StaticOrder, true, true>(lds, g, S, E); }
    }
    grid.sync();

    {
        pg8::Gemm g{MB, Wb + W_OUT, M, 1024, 1024}; pg8::StaticOrder S; S.init(M, 1024, G, bx);
        epi::EpiRes<true> E{x_p, x_s, out, XN, PART};
        pg8::gemm_phase<epi::EpiRes<true>, pg8::StaticOrder, true, true>(lds, g, S, E);
    }
    grid.sync();

    {
        pg8::Gemm g{XN, Wb + W_M1, M, DFF, 1024}; pg8::StaticOrder S; S.init(M, DFF, G, bx);
        epi::EpiMlpIn E{PART, HID};
        pg8::gemm_phase<epi::EpiMlpIn, pg8::StaticOrder, true, true>(lds, g, S, E);
    }
    grid.sync();

    {
        pg8::Gemm g{HID, Wb + W_M2, M, 1024, DFF}; pg8::StaticOrder S; S.init(M, 1024, G, bx);
        epi::EpiRes<false> E{nullptr, nullptr, out, nullptr, PART};
        pg8::gemm_phase<epi::EpiRes<false>, pg8::StaticOrder, true, true>(lds, g, S, E);
    }
    grid.sync();

    for (int m = gw; m < M; m += NGW) {
        const f32x4* pp = (const f32x4*)(PART + (size_t)m * 16); const f32x4 p0 = pp[0], p1 = pp[1], p2 = pp[2], p3 = pp[3];
        const float s = ((p0[0] + p0[1]) + (p0[2] + p0[3])) + ((p1[0] + p1[1]) + (p1[2] + p1[3])) + ((p2[0] + p2[1]) + (p2[2] + p2[3])) + ((p3[0] + p3[1]) + (p3[2] + p3[3]));
        const float rstd = 1.f / sqrtf(s * (1.f / 1024.f) + 1e-6f);
        float* orow = out + (size_t)m * 1024;
#pragma unroll
        for (int j = 0; j < 4; ++j) { f32x4 v = *(const f32x4*)(orow + 4 * lane + 256 * j); const f32x4 gn = *(const f32x4*)(fnorm + 4 * lane + 256 * j);
            v = v * rstd * gn; *(f32x4*)(orow + 4 * lane + 256 * j) = v; }
    }
}

extern "C" void kernel_launch(void* const* d_in, const int* in_sizes, int n_in, void* d_out, int out_size, void* d_ws, size_t ws_size, hipStream_t stream) {
    static int grid = 0;
    if (grid == 0) {
        if (n_in != 18 || out_size != M * DM || ws_size < WS_END) { fprintf(stderr, "kernel_launch: unexpected sizes n_in %d out %d ws %zu\n", n_in, out_size, ws_size); grid = -1; return; }
        int dev = 0, cus = 0, per_cu = 0;
        hipGetDevice(&dev); hipDeviceGetAttribute(&cus, hipDeviceAttributeMultiprocessorCount, dev);
        hipFuncSetAttribute((const void*)fwd_megakernel, hipFuncAttributeMaxDynamicSharedMemorySize, LDS_BYTES);
        hipOccupancyMaxActiveBlocksPerMultiprocessor(&per_cu, (const void*)fwd_megakernel, 512, LDS_BYTES);
        if (per_cu < 1) per_cu = 1;
        (void)hipGetLastError();
        grid = cus * per_cu;
    }
    if (grid < 0) return;
    Args a{};
    for (int i = 0; i < 18; ++i) a.in[i] = (const float*)d_in[i];
    a.out = (float*)d_out; a.ws = (unsigned char*)d_ws; a.grid_expect = grid; a.pad = 0;
    void* kargs[] = {&a};
    hipError_t e = hipLaunchCooperativeKernel((const void*)fwd_megakernel, dim3(grid), dim3(512), kargs, LDS_BYTES, stream);
    if (e != hipSuccess) fprintf(stderr, "cooperative launch failed: %s (grid %d)\n", hipGetErrorString(e), grid);
}
```

```cpp
#include <hip/hip_runtime.h>
#include <hip/hip_cooperative_groups.h>
#include <cstdio>
#include <cstdint>
namespace cg = cooperative_groups;
namespace pg8 {
#define PG8_LAS __attribute__((address_space(3)))
typedef unsigned short bf16_t;
typedef short bf16x8 __attribute__((ext_vector_type(8)));
typedef float f32x4 __attribute__((ext_vector_type(4)));
typedef unsigned u32x4 __attribute__((ext_vector_type(4)));
constexpr int BM = 256, BK = 64, HALF = 128, HTB = HALF * BK * 2  , STAGE_BYTES = 8 * HTB, NXCD = 8, WGM = 8;

__host__ __device__ __forceinline__ int lds_byte(int r, int c) { const int st = (r >> 4) * 2 + (c >> 5), rr = r & 15, cc = c & 31, ob = rr * 64 + cc * 2; return st * 1024 + (ob ^ (((ob >> 9) & 1) << 5)); }
__host__ __device__ __forceinline__ void stage_rc(int b, int& R, int& C) { const int st = b / 1024, sb = b % 1024, swz = sb ^ (((sb >> 9) & 1) << 5); R = (st >> 1) * 16 + swz / 64; C = (st & 1) * 32 + (swz % 64) / 2; }
__host__ __device__ __forceinline__ int perm32(int rho) { const int n = rho >> 4, i = rho & 15; return 8 * (i >> 2) + 4 * n + (i & 3); }

struct Unit { int pm, pn; };
struct Gemm { const bf16_t* A; const bf16_t* Bt; int M, N, K; };

struct StaticOrder {
    int nM, nN, nwg, G, c;
    __host__ __device__ void init(int M, int N, int G_, int c_) { nM = M / BM; nN = N / BM; nwg = nM * nN; G = G_; c = c_; }
    __host__ __device__ bool next(int i, Unit& u) const {
        const long L = (long)i * G + c; if (L >= nwg) return false;
        int wgid = (int)L; { const int q = nwg / NXCD, r = nwg % NXCD, xcd = wgid % NXCD, off = wgid / NXCD; wgid = (xcd < r ? xcd * (q + 1) : r * (q + 1) + (xcd - r) * q) + off; }
        const int nig = WGM * nN, gid = wgid / nig, fm = gid * WGM, gsz = (nM - fm) < WGM ? (nM - fm) : WGM;
        u.pm = fm + ((wgid % nig) % gsz); u.pn = (wgid % nig) / gsz; return true;
    }
    __device__ __forceinline__ void a_ready(const Unit&) const {}
    __device__ __forceinline__ void done(const Unit&) const {}
};

__device__ __forceinline__ unsigned cvt_pk_bf16(float lo, float hi) { unsigned r; asm volatile("v_cvt_pk_bf16_f32 %0, %1, %2" : "=v"(r) : "v"(lo), "v"(hi)); return r; }
template <class Epi, class Sched, bool ALIGN_EPI = false, bool SP2 = false>
__device__ __forceinline__ void gemm_phase(PG8_LAS unsigned char* lds, const Gemm g, const Sched& S, const Epi& E) {
    int tid_ = threadIdx.x; asm volatile("" : "+v"(tid_)); const int tid = tid_, wid = __builtin_amdgcn_readfirstlane(tid >> 6), lane = tid & 63, wr = wid >> 2, wc = wid & 3, fr = lane & 15, fq = lane >> 4;
    const int K = g.K, nt = K / BK;
    unsigned voffA[2], voffB[2];
#pragma unroll
    for (int i = 0; i < 2; ++i) { int R, C; stage_rc(tid * 16 + i * 8192, R, C); const int Rb = Epi::PERM ? ((R & ~31) + perm32(R & 31)) : R;
        voffA[i] = (unsigned)(R * K + C) * 2u; voffB[i] = (unsigned)(Rb * K + C) * 2u; }
    const size_t kstep = (size_t)(BK * 2);
    const size_t hstep = (size_t)HALF * K * 2;
    const size_t tstep = 2 * hstep;
    const unsigned ldsw = (unsigned)wid * 1024u;
    const int aoff = lds_byte(wr * 64 + fr, fq * 8), boff = lds_byte(wc * 32 + fr, fq * 8);
#define PG8_SA(b, h) (((b) * 2 + (h)) * HTB)
#define PG8_SB(b, h) ((4 + (b) * 2 + (h)) * HTB)
#define PG8_STAGE(bufoff, gbase, voff) do { _Pragma("unroll") for (int _i = 0; _i < 2; ++_i) \
        __builtin_amdgcn_global_load_lds((const unsigned*)((const char*)(gbase) + (voff)[_i]), (PG8_LAS unsigned*)(lds + (bufoff) + ldsw + _i * 8192), 16, 0, 0); } while (0)
#define PG8_LDA(dst, b, h) do { _Pragma("unroll") for (int m = 0; m < 4; ++m) _Pragma("unroll") for (int k = 0; k < 2; ++k) dst[m][k] = *(const PG8_LAS bf16x8*)(lds + PG8_SA(b, h) + aoff + m * 2048 + k * 1024); } while (0)
#define PG8_LDB(dst, b, h) do { _Pragma("unroll") for (int n = 0; n < 2; ++n) _Pragma("unroll") for (int k = 0; k < 2; ++k) dst[n][k] = *(const PG8_LAS bf16x8*)(lds + PG8_SB(b, h) + boff + n * 2048 + k * 1024); } while (0)
#define PG8_MMA(ai, bj, At, Bt) do { __builtin_amdgcn_s_setprio(1); _Pragma("unroll") for (int m = 0; m < 4; ++m) _Pragma("unroll") for (int n = 0; n < 2; ++n) _Pragma("unroll") for (int k = 0; k < 2; ++k) \
        acc[ai][bj][m][n] = __builtin_amdgcn_mfma_f32_16x16x32_bf16(Bt[n][k], At[m][k], acc[ai][bj][m][n], 0, 0, 0); __builtin_amdgcn_s_setprio(0); } while (0)
#define PG8_WAIT_V(n) asm volatile("s_waitcnt vmcnt(" #n ")" ::: "memory")
#define PG8_WAIT_L(n) asm volatile("s_waitcnt lgkmcnt(" #n ")" ::: "memory")
#define PG8_BAR __builtin_amdgcn_s_barrier()
#define PG8_SCHED __builtin_amdgcn_sched_barrier(0)
    Unit cur, nxt; int ui = 0;
    if (!S.next(0, cur)) return;
    f32x4 acc[2][2][4][2];
#pragma unroll
    for (int a = 0; a < 2; ++a)
#pragma unroll
        for (int b = 0; b < 2; ++b)
#pragma unroll
            for (int m = 0; m < 4; ++m)
#pragma unroll
                for (int n = 0; n < 2; ++n) acc[a][b][m][n] = (f32x4){0.f, 0.f, 0.f, 0.f};
    bf16x8 At[4][2], B0[2][2], B1[2][2];
    const char* cA = (const char*)g.A + (size_t)cur.pm * tstep; const char* cB = (const char*)g.Bt + (size_t)cur.pn * tstep;
    S.a_ready(cur);
    if constexpr (SP2) {
        PG8_STAGE(PG8_SB(0, 0), cB, voffB); PG8_STAGE(PG8_SB(0, 1), cB + hstep, voffB); PG8_STAGE(PG8_SA(0, 0), cA, voffA); PG8_STAGE(PG8_SA(0, 1), cA + hstep, voffA);
        if (wr == 1) PG8_BAR;
        PG8_WAIT_V(2); PG8_BAR;
        PG8_STAGE(PG8_SB(1, 0), cB + kstep, voffB); PG8_STAGE(PG8_SA(1, 0), cA + kstep, voffA); PG8_STAGE(PG8_SB(1, 1), cB + hstep + kstep, voffB);
        PG8_WAIT_V(6); PG8_BAR;
    } else {
        PG8_STAGE(PG8_SB(0, 0), cB, voffB); PG8_STAGE(PG8_SA(0, 0), cA, voffA); PG8_STAGE(PG8_SB(0, 1), cB + hstep, voffB); PG8_STAGE(PG8_SA(0, 1), cA + hstep, voffA);
        if (wr == 1) PG8_BAR;
        PG8_WAIT_V(4); PG8_BAR;
        PG8_STAGE(PG8_SB(1, 0), cB + kstep, voffB); PG8_STAGE(PG8_SA(1, 0), cA + kstep, voffA); PG8_STAGE(PG8_SB(1, 1), cB + hstep + kstep, voffB);
        PG8_WAIT_V(6); PG8_BAR;
    }
    for (;;) {
        const bool has_next = S.next(ui + 1, nxt);
        const char* nA = has_next ? (const char*)g.A + (size_t)nxt.pm * tstep : cA; const char* nB = has_next ? (const char*)g.Bt + (size_t)nxt.pn * tstep : cB;
        for (int t = 0; t < nt; t += 2) {
            const bool last = (t == nt - 2);
            const char* a1 = cA + (size_t)(t + 1) * kstep;
            const char* a2 = last ? nA : cA + (size_t)(t + 2) * kstep; const char* b2 = last ? nB : cB + (size_t)(t + 2) * kstep;
            const char* a3 = a2 + kstep; const char* b3 = b2 + kstep;
            if (last && has_next) S.a_ready(nxt);
            if constexpr (SP2) {
            PG8_LDB(B0, 0, 0); PG8_LDB(B1, 0, 1); PG8_SCHED; PG8_LDA(At, 0, 0); PG8_STAGE(PG8_SA(1, 1), a1 + hstep, voffA);
            PG8_WAIT_V(8); PG8_WAIT_L(0); PG8_BAR; PG8_MMA(0, 0, At, B0); PG8_MMA(0, 1, At, B1); PG8_BAR; PG8_SCHED;
            PG8_LDA(At, 0, 1); PG8_STAGE(PG8_SB(0, 0), b2, voffB); PG8_STAGE(PG8_SB(0, 1), b2 + hstep, voffB); PG8_STAGE(PG8_SA(0, 0), a2, voffA);
            PG8_WAIT_V(8); PG8_WAIT_L(0); PG8_BAR; PG8_MMA(1, 0, At, B0); PG8_MMA(1, 1, At, B1); PG8_BAR; PG8_SCHED;
            PG8_LDB(B0, 1, 0); PG8_LDB(B1, 1, 1); PG8_SCHED; PG8_LDA(At, 1, 0); PG8_STAGE(PG8_SA(0, 1), a2 + hstep, voffA);
            PG8_WAIT_V(8); PG8_WAIT_L(0); PG8_BAR; PG8_MMA(0, 0, At, B0); PG8_MMA(0, 1, At, B1); PG8_BAR; PG8_SCHED;
            PG8_LDA(At, 1, 1); PG8_STAGE(PG8_SB(1, 0), b3, voffB); PG8_STAGE(PG8_SB(1, 1), b3 + hstep, voffB); PG8_STAGE(PG8_SA(1, 0), a3, voffA);
            PG8_WAIT_V(8); PG8_WAIT_L(0); PG8_BAR; PG8_MMA(1, 0, At, B0); PG8_MMA(1, 1, At, B1); PG8_BAR; PG8_SCHED;
            } else {
            PG8_LDB(B0, 0, 0); PG8_SCHED; PG8_LDA(At, 0, 0); PG8_STAGE(PG8_SA(1, 1), a1 + hstep, voffA);
            PG8_WAIT_L(8); PG8_BAR; PG8_WAIT_L(0); PG8_MMA(0, 0, At, B0); PG8_BAR; PG8_SCHED;
            PG8_LDB(B1, 0, 1); PG8_STAGE(PG8_SB(0, 0), b2, voffB);
            PG8_BAR; PG8_WAIT_L(0); PG8_MMA(0, 1, At, B1); PG8_BAR;
            PG8_LDA(At, 0, 1); PG8_STAGE(PG8_SA(0, 0), a2, voffA);
            PG8_BAR; PG8_WAIT_L(0); PG8_MMA(1, 0, At, B0); PG8_BAR; PG8_SCHED;
            PG8_STAGE(PG8_SB(0, 1), b2 + hstep, voffB);
            PG8_WAIT_V(6); PG8_BAR; PG8_MMA(1, 1, At, B1); PG8_BAR;
            PG8_LDB(B0, 1, 0); PG8_SCHED; PG8_LDA(At, 1, 0); PG8_STAGE(PG8_SA(0, 1), a2 + hstep, voffA);
            PG8_WAIT_L(8); PG8_BAR; PG8_WAIT_L(0); PG8_MMA(0, 0, At, B0); PG8_BAR; PG8_SCHED;
            PG8_LDB(B1, 1, 1); PG8_STAGE(PG8_SB(1, 0), b3, voffB);
            PG8_BAR; PG8_WAIT_L(0); PG8_MMA(0, 1, At, B1); PG8_BAR;
            PG8_LDA(At, 1, 1); PG8_STAGE(PG8_SA(1, 0), a3, voffA);
            PG8_BAR; PG8_WAIT_L(0); PG8_MMA(1, 0, At, B0); PG8_BAR; PG8_SCHED;
            PG8_STAGE(PG8_SB(1, 1), b3 + hstep, voffB);
            PG8_WAIT_V(6); PG8_BAR; PG8_MMA(1, 1, At, B1); PG8_BAR;
            }
        }
        if constexpr (ALIGN_EPI) { if (wr == 0) PG8_BAR; }
        if constexpr (!Epi::AFTER_DRAIN) { E(acc, cur, wr, wc, fr, fq); S.done(cur); }
        if (!has_next) break;
#pragma unroll
        for (int a = 0; a < 2; ++a)
#pragma unroll
            for (int b = 0; b < 2; ++b)
#pragma unroll
                for (int m = 0; m < 4; ++m)
#pragma unroll
                    for (int n = 0; n < 2; ++n) acc[a][b][m][n] = (f32x4){0.f, 0.f, 0.f, 0.f};
        cur = nxt; cA = nA; cB = nB; ++ui;
        if constexpr (ALIGN_EPI) { if (wr == 1) PG8_BAR; }
    }
    PG8_WAIT_V(0);
    if constexpr (!ALIGN_EPI) { if (wr == 0) PG8_BAR; }
    PG8_BAR;
    if constexpr (Epi::AFTER_DRAIN) { E.fused(acc, cur, wr, wc, fr, fq, lds, wid, lane); S.done(cur); }
#undef PG8_SA
#undef PG8_SB
#undef PG8_STAGE
#undef PG8_LDA
#undef PG8_LDB
#undef PG8_MMA
#undef PG8_WAIT_V
#undef PG8_WAIT_L
#undef PG8_BAR
#undef PG8_SCHED
}
}

constexpr int DM = 1024, TP = 2048, TS = 8192, MP = 8 * TP, MS = 8 * TS, M = MP + MS;
constexpr int INW = 6144, DFF = 4096;
constexpr size_t MiB = 1u << 20;
constexpr size_t WS_CTL = 0, WS_ROPE = 1 * MiB, WS_PART = 2 * MiB, WS_W = 8 * MiB, WS_XN = 40 * MiB, WS_OHF = 40 * MiB, WS_OHB = 120 * MiB;
constexpr size_t WS_Q = 200 * MiB, WS_K = 280 * MiB, WS_V = 360 * MiB, WS_QH = 440 * MiB, WS_I = 520 * MiB, WS_G = 600 * MiB, WS_F = 680 * MiB;
constexpr size_t WS_MB = 280 * MiB, WS_HID = 200 * MiB, WS_END = 1000 * MiB;
constexpr size_t W_IN = 0, W_HG = (size_t)INW * DM, W_DA = W_HG + 512 * 1024, W_OUT = W_DA + 512 * 1024, W_M1 = W_OUT + 1024 * 1024, W_M2 = W_M1 + (size_t)DFF * DM;
constexpr int LDS_BYTES = 147456;
constexpr float LOG2E = 1.4426950408889634f;
constexpr float C2 = 0.125f * LOG2E;
constexpr float HG_SCALE = 0.08838834764831845f;

#define LAS __attribute__((address_space(3)))
typedef unsigned short bf16_t;
typedef short bf16x8 __attribute__((ext_vector_type(8)));
typedef short s16x4 __attribute__((ext_vector_type(4)));
typedef float f32x4 __attribute__((ext_vector_type(4)));
typedef float f32x16 __attribute__((ext_vector_type(16)));
typedef unsigned u32x4 __attribute__((ext_vector_type(4)));
typedef unsigned u32x2 __attribute__((ext_vector_type(2)));

typedef float f32x2_t __attribute__((ext_vector_type(2))); typedef __bf16 bf16x2_t __attribute__((ext_vector_type(2)));
__device__ __forceinline__ unsigned cvtpk(float lo, float hi) { f32x2_t v = {lo, hi}; bf16x2_t b = __builtin_convertvector(v, bf16x2_t); return __builtin_bit_cast(unsigned, b); }
__device__ __forceinline__ float bf2f(unsigned short b) { return __uint_as_float((unsigned)b << 16); }
__device__ __forceinline__ float bflo(unsigned w) { return __uint_as_float(w << 16); }
__device__ __forceinline__ float bfhi(unsigned w) { return __uint_as_float(w & 0xffff0000u); }
__device__ __forceinline__ float ex2(float x) { return __builtin_amdgcn_exp2f(x); }
__device__ __forceinline__ float sigm(float v) { return __builtin_amdgcn_rcpf(1.f + ex2(-v * LOG2E)); }
__device__ __forceinline__ int crow(int i, int h) { return (i & 3) + 8 * (i >> 2) + 4 * h; }
__device__ __forceinline__ float swap_max(float m) { auto rr = __builtin_amdgcn_permlane32_swap(__float_as_uint(m), __float_as_uint(m), false, false); return fmaxf(__uint_as_float(rr[0]), __uint_as_float(rr[1])); }
__device__ __forceinline__ float swap_sum(float m) { auto rr = __builtin_amdgcn_permlane32_swap(__float_as_uint(m), __float_as_uint(m), false, false); return __uint_as_float(rr[0]) + __uint_as_float(rr[1]); }
#define MFMA32(a, b, c) __builtin_amdgcn_mfma_f32_32x32x16_bf16((a), (b), (c), 0, 0, 0)

namespace epi {
using pg8::Unit; using pg8::f32x4;
__device__ __forceinline__ void st8(bf16_t* p, f32x4 a, f32x4 b) { u32x4 w; w.x = cvtpk(a[0], a[1]); w.y = cvtpk(a[2], a[3]); w.z = cvtpk(b[0], b[1]); w.w = cvtpk(b[2], b[3]); *(u32x4*)p = w; }

struct EpiIn {
    static constexpr bool PERM = true, AFTER_DRAIN = false;
    bf16_t *Q, *K, *V, *QH, *I, *G, *GATES; float* F; const float* lbl; const float* rope;
    __device__ __forceinline__ void operator()(const f32x4 (&acc)[2][2][4][2], const Unit& u, int wr, int wc, int fr, int fq) const {
        const int pn = u.pn, row0 = u.pm * 256 + wr * 64 + fr, cw = wc * 32 + 8 * fq;
        if (pn >= 16) {
            const int col0 = (pn - 16) * 256 + cw;
#pragma unroll
            for (int ai = 0; ai < 2; ++ai)
#pragma unroll
                for (int m = 0; m < 4; ++m) { bf16_t* rp = GATES + (size_t)(row0 + ai * 128 + m * 16) * 2048 + col0;
#pragma unroll
                    for (int bj = 0; bj < 2; ++bj) { f32x4 a = acc[ai][bj][m][0], b = acc[ai][bj][m][1];
#pragma unroll
                        for (int e = 0; e < 4; ++e) { a[e] = sigm(a[e]); b[e] = sigm(b[e]); }
                        st8(rp + bj * 128, a, b); } }
            return;
        }
        const int sec = pn >> 1, col0 = (pn & 1) * 256 + cw;
        if (sec == 4 || sec == 5) {
            const int d = sec - 4;
            f32x4 lb[2][2];
#pragma unroll
            for (int bj = 0; bj < 2; ++bj)
#pragma unroll
                for (int n = 0; n < 2; ++n) { const f32x4 l0 = *(const f32x4*)(lbl + d * 1024 + col0 + bj * 128 + 4 * n), l1 = *(const f32x4*)(lbl + d * 1024 + 512 + col0 + bj * 128 + 4 * n);
#pragma unroll
                    for (int e = 0; e < 4; ++e) lb[bj][n][e] = sigm(l0[e] - l1[e]); }
#pragma unroll
            for (int ai = 0; ai < 2; ++ai)
#pragma unroll
                for (int m = 0; m < 4; ++m) { float* rp = F + (size_t)(row0 + ai * 128 + m * 16) * 1024 + d * 512 + col0;
#pragma unroll
                    for (int bj = 0; bj < 2; ++bj)
#pragma unroll
                        for (int n = 0; n < 2; ++n) { f32x4 a = acc[ai][bj][m][n];
#pragma unroll
                            for (int e = 0; e < 4; ++e) a[e] = lb[bj][n][e] + (1.f - lb[bj][n][e]) * sigm(a[e]);
                            *(f32x4*)(rp + bj * 128 + 4 * n) = a; } }
            return;
        }
        bf16_t* base = sec == 0 ? Q : sec == 1 ? K : sec == 2 ? V : sec == 3 ? QH : sec == 6 ? I : G;
        const bool rot = (sec < 2) && ((wc & 1) == 0);
#pragma unroll
        for (int ai = 0; ai < 2; ++ai)
#pragma unroll
            for (int m = 0; m < 4; ++m) { const int row = row0 + ai * 128 + m * 16; bf16_t* rp = base + (size_t)row * 512 + col0;
                f32x4 cs[4];
                if (rot) { const int pos = row < MP ? (row & (TP - 1)) : ((row - MP) & (TS - 1)); const f32x4* rt = (const f32x4*)(rope + (size_t)pos * 16);
#pragma unroll
                    for (int k = 0; k < 4; ++k) cs[k] = rt[k]; }
#pragma unroll
                for (int bj = 0; bj < 2; ++bj) { f32x4 a = acc[ai][bj][m][0], b = acc[ai][bj][m][1];
                    if (sec < 2) {
                        if (rot) {
#pragma unroll
                            for (int e = 0; e < 4; ++e) { const float pa = __shfl_xor(a[e], 16), pb = __shfl_xor(b[e], 16);
                                const float ca = cs[e >> 1][(e & 1) * 2], sa = cs[e >> 1][(e & 1) * 2 + 1], cb = cs[2 + (e >> 1)][(e & 1) * 2], sb = cs[2 + (e >> 1)][(e & 1) * 2 + 1];
                                if (fq == 0) { a[e] = a[e] * ca - pa * sa; b[e] = b[e] * cb - pb * sb; }
                                else if (fq == 1) { a[e] = a[e] * ca + pa * sa; b[e] = b[e] * cb + pb * sb; } }
                        }
                        if (sec == 0) { a = a * C2; b = b * C2; }
                    } else if (sec == 3) {
#pragma unroll
                        for (int e = 0; e < 4; ++e) { a[e] = a[e] * sigm(a[e]) * HG_SCALE; b[e] = b[e] * sigm(b[e]) * HG_SCALE; }
                    } else if (sec == 7) {
#pragma unroll
                        for (int e = 0; e < 4; ++e) { a[e] = a[e] * sigm(a[e]); b[e] = b[e] * sigm(b[e]); }
                    }
                    st8(rp + bj * 128, a, b); } }
    }
};

template <int MODE> struct EpiGate {
    static constexpr bool PERM = true, AFTER_DRAIN = false;
    const bf16_t* GATES; bf16_t* MB;
    __device__ __forceinline__ void operator()(const f32x4 (&acc)[2][2][4][2], const Unit& u, int wr, int wc, int fr, int fq) const {
        const int row0 = u.pm * 256 + wr * 64 + fr, col0 = u.pn * 256 + wc * 32 + 8 * fq;
#pragma unroll
        for (int ai = 0; ai < 2; ++ai)
#pragma unroll
            for (int m = 0; m < 4; ++m) { const int row = row0 + ai * 128 + m * 16;
#pragma unroll
                for (int bj = 0; bj < 2; ++bj) { const int col = col0 + bj * 128;
                    const u32x4 g = *(const u32x4*)(GATES + (size_t)row * 2048 + MODE * 1024 + col);
                    f32x4 a = acc[ai][bj][m][0], b = acc[ai][bj][m][1];
                    a[0] *= bflo(g.x); a[1] *= bfhi(g.x); a[2] *= bflo(g.y); a[3] *= bfhi(g.y); b[0] *= bflo(g.z); b[1] *= bfhi(g.z); b[2] *= bflo(g.w); b[3] *= bfhi(g.w);
                    bf16_t* mp = MB + (size_t)row * 1024 + col;
                    if (MODE == 1) { const u32x4 p = *(const u32x4*)mp;
                        a[0] += bflo(p.x); a[1] += bfhi(p.x); a[2] += bflo(p.y); a[3] += bfhi(p.y); b[0] += bflo(p.z); b[1] += bfhi(p.z); b[2] += bflo(p.w); b[3] += bfhi(p.w); }
                    st8(mp, a, b); } }
    }
};

template <bool WITH_XB> struct EpiRes {
    static constexpr bool PERM = true, AFTER_DRAIN = false;
    const float* xp; const float* xs; float* OUT; bf16_t* XB; float* PART;
    __device__ __forceinline__ void operator()(const f32x4 (&acc)[2][2][4][2], const Unit& u, int wr, int wc, int fr, int fq) const {
        const int row0 = u.pm * 256 + wr * 64 + fr, col0 = u.pn * 256 + wc * 32 + 8 * fq;
#pragma unroll
        for (int ai = 0; ai < 2; ++ai)
#pragma unroll
            for (int m = 0; m < 4; ++m) { const int row = row0 + ai * 128 + m * 16; float ss = 0.f;
                const float* bp = xp ? (row < MP ? xp + (size_t)row * 1024 : xs + (size_t)(row - MP) * 1024) : OUT + (size_t)row * 1024;
#pragma unroll
                for (int bj = 0; bj < 2; ++bj) { const int col = col0 + bj * 128;
                    f32x4 a = acc[ai][bj][m][0] + *(const f32x4*)(bp + col), b = acc[ai][bj][m][1] + *(const f32x4*)(bp + col + 4);
                    *(f32x4*)(OUT + (size_t)row * 1024 + col) = a; *(f32x4*)(OUT + (size_t)row * 1024 + col + 4) = b;
                    if (WITH_XB) st8(XB + (size_t)row * 1024 + col, a, b);
                    ss += (a[0] * a[0] + a[1] * a[1]) + (a[2] * a[2] + a[3] * a[3]) + (b[0] * b[0] + b[1] * b[1]) + (b[2] * b[2] + b[3] * b[3]); }
                ss += __shfl_xor(ss, 16); ss += __shfl_xor(ss, 32);
                if (fq == 0) PART[(size_t)row * 16 + u.pn * 4 + wc] = ss; }
    }
};

struct EpiMlpIn {
    static constexpr bool PERM = true, AFTER_DRAIN = false;
    const float* PART; bf16_t* HID;
    __device__ __forceinline__ void operator()(const f32x4 (&acc)[2][2][4][2], const Unit& u, int wr, int wc, int fr, int fq) const {
        const int row0 = u.pm * 256 + wr * 64 + fr, col0 = u.pn * 256 + wc * 32 + 8 * fq;
#pragma unroll
        for (int ai = 0; ai < 2; ++ai)
#pragma unroll
            for (int m = 0; m < 4; ++m) { const int row = row0 + ai * 128 + m * 16;
                const f32x4* pp = (const f32x4*)(PART + (size_t)row * 16); const f32x4 p0 = pp[0], p1 = pp[1], p2 = pp[2], p3 = pp[3];
                const float s = ((p0[0] + p0[1]) + (p0[2] + p0[3])) + ((p1[0] + p1[1]) + (p1[2] + p1[3])) + ((p2[0] + p2[1]) + (p2[2] + p2[3])) + ((p3[0] + p3[1]) + (p3[2] + p3[3]));
                const float r2 = 1.f / (s * (1.f / 1024.f) + 1e-6f);
#pragma unroll
                for (int bj = 0; bj < 2; ++bj) { f32x4 a = acc[ai][bj][m][0], b = acc[ai][bj][m][1];
#pragma unroll
                    for (int e = 0; e < 4; ++e) { const float x = fmaxf(a[e], 0.f), y = fmaxf(b[e], 0.f); a[e] = x * x * r2; b[e] = y * y * r2; }
                    st8(HID + (size_t)row * DFF + col0 + bj * 128, a, b); } }
    }
};
}

__device__ __forceinline__ float wave_sum(float v) {
#pragma unroll
    for (int o = 1; o < 64; o <<= 1) v += __shfl_xor(v, o);
    return v;
}
__device__ __forceinline__ void transpose_item(const float* W, int K, int N, bf16_t* WT, const float* sc, LAS float* scr, int item, int lane) {
    const int nblk = N / 32, kb = item / nblk, nb = item % nblk, k0 = 64 * kb, n0 = 32 * nb;
#pragma unroll 8
    for (int i = 0; i < 32; ++i) { const int kk = 2 * i + (lane >> 5); float v = W[(size_t)(k0 + kk) * N + n0 + (lane & 31)]; if (sc) v *= sc[k0 + kk]; scr[kk * 33 + (lane & 31)] = v; }
    asm volatile("s_waitcnt lgkmcnt(0)" ::: "memory");
    const int c = lane & 7;
#pragma unroll
    for (int j = 0; j < 4; ++j) { const int n = (lane >> 3) + 8 * j; const LAS float* s = scr + (8 * c) * 33 + n;
        u32x4 o; o.x = cvtpk(s[0 * 33], s[1 * 33]); o.y = cvtpk(s[2 * 33], s[3 * 33]); o.z = cvtpk(s[4 * 33], s[5 * 33]); o.w = cvtpk(s[6 * 33], s[7 * 33]);
        *(u32x4*)(WT + (size_t)(n0 + n) * K + k0 + 8 * c) = o; }
    asm volatile("s_waitcnt lgkmcnt(0)" ::: "memory");
}

struct Args {
    const float* in[18]; float* out; unsigned char* ws; int grid_expect; int pad;
};

namespace att {
constexpr int KROW = 144, VROW = 320, KTILE = 64 * KROW, KBUF = 2 * KTILE, VBUF = 64 * VROW;
constexpr int OFF_K = 0, OFF_V = 2 * KBUF, OFF_X = OFF_V + 2 * VBUF, OFF_MISC = OFF_X + 65536;
static_assert(OFF_MISC + 64 <= LDS_BYTES, "attention LDS map");
typedef short v4i16_t __attribute__((ext_vector_type(4)));
__device__ __forceinline__ s16x4 vtr(const LAS char* p) { return __builtin_bit_cast(s16x4, __builtin_amdgcn_ds_read_tr16_b64_v4i16((LAS v4i16_t*)p)); }
__device__ __forceinline__ float max3f(float a, float b, float c) { float r; asm("v_max3_f32 %0, %1, %2, %3" : "=v"(r) : "v"(a), "v"(b), "v"(c)); return r; }
#define HBAR() do { asm volatile("s_waitcnt lgkmcnt(0)\n\ts_barrier" ::: "memory"); __builtin_amdgcn_sched_barrier(0); } while (0)
#define HBAR_S() do { asm volatile("s_waitcnt lgkmcnt(0)\n\ts_barrier\n\ts_nop 15\n\ts_nop 7" : "+v"(s0), "+v"(s1) :: "memory"); __builtin_amdgcn_sched_barrier(0); } while (0)

__device__ __forceinline__ void attn_unit(LAS char* lds, int seqbase, int T, int h, int qb, const bf16_t* Qb, const bf16_t* Kb, const bf16_t* Vb, bf16_t* OA, float lam, const float* subln) {
    int tid_ = threadIdx.x; asm volatile("" : "+v"(tid_));
    const int tid = tid_, lane = tid & 63, r = lane & 31, hh = lane >> 5, w = __builtin_amdgcn_readfirstlane(tid >> 6), comp = w >> 2, qs = w & 3;
    const size_t qrow = (size_t)seqbase + qb * 128 + qs * 32 + r;
    bf16x8 qf[4];
#pragma unroll
    for (int d0 = 0; d0 < 4; ++d0) qf[d0] = *(const bf16x8*)(Qb + qrow * 512 + (2 * h + comp) * 64 + d0 * 16 + hh * 8);
    f32x16 o[4];
#pragma unroll
    for (int vt = 0; vt < 4; ++vt)
#pragma unroll
        for (int i = 0; i < 16; ++i) o[vt][i] = 0.f;
    constexpr float THR = 8.f;
    float mref = 0.f, lrun = 0.f; f32x16 negm;
#pragma unroll
    for (int i = 0; i < 16; ++i) negm[i] = 0.f;
    const int NT = T / 64;
    const bf16_t* ksrc = Kb + ((size_t)seqbase + (tid >> 3)) * 512 + (2 * h) * 64 + (tid & 7) * 8;
    const bf16_t* vsrc = Vb + ((size_t)seqbase + (tid >> 4)) * 512 + h * 128 + (tid & 15) * 8;
    const int kdst = OFF_K + (tid >> 3) * KROW + (tid & 7) * 16, vdst = OFF_V + (tid >> 4) * VROW + (tid & 15) * 16;
    u32x4 kr0, kr1, vr0, vr1;
    const int i16 = lane & 15, q4 = i16 >> 2, p4 = i16 & 3, blk = (lane >> 4) & 1;
    const int vlane = (4 * hh + q4) * VROW + (16 * blk + 4 * p4) * 2;
    const int klane = comp * KTILE + r * KROW + hh * 16;
    f32x16 s0, s1; bf16x8 pf[4];
#define LOADP(t) do { if ((t) + 1 < NT) { const size_t adv_ = (size_t)((t) + 1) * 64 * 512; kr0 = *(const u32x4*)(ksrc + adv_); kr1 = *(const u32x4*)(ksrc + adv_ + 64); } \
                      if ((t) < NT) { const size_t adv_ = (size_t)(t) * 64 * 512; vr0 = *(const u32x4*)(vsrc + adv_); vr1 = *(const u32x4*)(vsrc + adv_ + 32 * 512); } } while (0)
#define WRITEP(t) do { if ((t) + 1 < NT) { const int nb_ = ((t) + 1) & 1; *(LAS u32x4*)(lds + kdst + nb_ * KBUF) = kr0; *(LAS u32x4*)(lds + kdst + nb_ * KBUF + KTILE) = kr1; } \
                       if ((t) < NT) { const int nb_ = (t) & 1; *(LAS u32x4*)(lds + vdst + nb_ * VBUF) = vr0; *(LAS u32x4*)(lds + vdst + nb_ * VBUF + 32 * VROW) = vr1; } } while (0)
#define MPHASE(t) do { \
        if ((t) >= 1) { const LAS char* vb_ = lds + OFF_V + (((t) - 1) & 1) * VBUF + vlane; \
            _Pragma("unroll") for (int ks = 0; ks < 4; ++ks) { \
                _Pragma("unroll") for (int vt = 0; vt < 4; ++vt) { \
                    const s16x4 lo_ = vtr(vb_ + (16 * ks) * VROW + vt * 64), hi_ = vtr(vb_ + (16 * ks + 8) * VROW + vt * 64); \
                    const bf16x8 vf_ = __builtin_shufflevector(lo_, hi_, 0, 1, 2, 3, 4, 5, 6, 7); \
                    o[vt] = MFMA32(vf_, pf[ks], o[vt]); } } } \
        if ((t) < NT) { const LAS char* kb_ = lds + OFF_K + ((t) & 1) * KBUF + klane; \
            _Pragma("unroll") for (int d0 = 0; d0 < 4; ++d0) { \
                const bf16x8 a0_ = *(const LAS bf16x8*)(kb_ + d0 * 32), a1_ = *(const LAS bf16x8*)(kb_ + 32 * KROW + d0 * 32); \
                if (d0 == 0) { s0 = MFMA32(a0_, qf[0], negm); s1 = MFMA32(a1_, qf[0], negm); } \
                else { s0 = MFMA32(a0_, qf[d0], s0); s1 = MFMA32(a1_, qf[d0], s1); } } } } while (0)
#define VPHASE(FIRST) do { \
        float mxa_ = max3f(s0[0], s0[1], s1[0]), mxb_ = max3f(s0[2], s0[3], s1[1]); mxa_ = max3f(mxa_, s1[2], s1[3]); \
        _Pragma("unroll") for (int i = 4; i < 16; i += 4) { mxa_ = max3f(mxa_, s0[i], s0[i + 1]); mxb_ = max3f(mxb_, s0[i + 2], s0[i + 3]); mxa_ = max3f(mxa_, s1[i], s1[i + 1]); mxb_ = max3f(mxb_, s1[i + 2], s1[i + 3]); } \
        const float mx_ = swap_max(fmaxf(mxa_, mxb_)); \
        if (__any(mx_ > THR) || (FIRST)) {                         \
            const float dl_ = (FIRST) ? mx_ : fmaxf(mx_, 0.f); mref += dl_; \
            _Pragma("unroll") for (int i = 0; i < 16; ++i) { s0[i] -= dl_; s1[i] -= dl_; negm[i] = -mref; } \
            const float f_ = (FIRST) ? 1.f : ex2(-dl_); lrun *= f_; \
            _Pragma("unroll") for (int vt = 0; vt < 4; ++vt) _Pragma("unroll") for (int i = 0; i < 16; ++i) o[vt][i] *= f_; } \
        float ls_ = 0.f; \
        _Pragma("unroll") for (int i = 0; i < 16; ++i) { s0[i] = ex2(s0[i]); s1[i] = ex2(s1[i]); ls_ += s0[i] + s1[i]; } \
        lrun += ls_; \
        _Pragma("unroll") for (int s = 0; s < 2; ++s) { u32x4 a_, b_; \
            a_.x = cvtpk(s0[8 * s + 0], s0[8 * s + 1]); a_.y = cvtpk(s0[8 * s + 2], s0[8 * s + 3]); a_.z = cvtpk(s0[8 * s + 4], s0[8 * s + 5]); a_.w = cvtpk(s0[8 * s + 6], s0[8 * s + 7]); \
            b_.x = cvtpk(s1[8 * s + 0], s1[8 * s + 1]); b_.y = cvtpk(s1[8 * s + 2], s1[8 * s + 3]); b_.z = cvtpk(s1[8 * s + 4], s1[8 * s + 5]); b_.w = cvtpk(s1[8 * s + 6], s1[8 * s + 7]); \
            pf[s] = __builtin_bit_cast(bf16x8, a_); pf[2 + s] = __builtin_bit_cast(bf16x8, b_); } } while (0)

    kr0 = *(const u32x4*)(ksrc); kr1 = *(const u32x4*)(ksrc + 64);
    *(LAS u32x4*)(lds + kdst) = kr0; *(LAS u32x4*)(lds + kdst + KTILE) = kr1;
    LOADP(0);
    HBAR();
    if (comp == 0) {
        MPHASE(0); HBAR_S();
        for (int t = 0; t < NT; ++t) {
            VPHASE(t == 0); WRITEP(t); LOADP(t + 1); HBAR();
            MPHASE(t + 1); HBAR_S();
        }
        HBAR();
    } else {
        WRITEP(0); LOADP(1); HBAR();
        for (int t = 0; t < NT; ++t) {
            MPHASE(t); HBAR_S();
            VPHASE(t == 0); WRITEP(t + 1); LOADP(t + 2); HBAR();
        }
        MPHASE(NT); HBAR();
    }
#undef LOADP
#undef WRITEP
#undef MPHASE
#undef VPHASE
    lrun = swap_sum(lrun);
    const float inv = 1.f / lrun;
    LAS float* X = (LAS float*)(lds + OFF_X) + qs * 4096 + lane;
    if (comp == 1) {
        const float sc = inv * lam;
#pragma unroll
        for (int vt = 0; vt < 4; ++vt)
#pragma unroll
            for (int i = 0; i < 16; ++i) X[(vt * 16 + i) * 64] = o[vt][i] * sc;
    }
    __syncthreads();
    if (comp == 0) {
        float ss = 0.f;
#pragma unroll
        for (int vt = 0; vt < 4; ++vt)
#pragma unroll
            for (int i = 0; i < 16; ++i) { const float d = o[vt][i] * inv - X[(vt * 16 + i) * 64]; o[vt][i] = d; ss += d * d; }
        ss = swap_sum(ss);
        const float rs = 0.8f / sqrtf(ss * (1.f / 128.f) + 1e-5f);
        bf16_t* op = OA + qrow * 512 + h * 128;
#pragma unroll
        for (int vt = 0; vt < 4; ++vt)
#pragma unroll
            for (int g = 0; g < 4; ++g) { const int v = 32 * vt + 8 * g + 4 * hh; const f32x4 sw = *(const f32x4*)(subln + v);
                u32x2 wv; wv.x = cvtpk(o[vt][4 * g] * rs * sw[0], o[vt][4 * g + 1] * rs * sw[1]); wv.y = cvtpk(o[vt][4 * g + 2] * rs * sw[2], o[vt][4 * g + 3] * rs * sw[3]);
                *(u32x2*)(op + v) = wv; }
    }
    __syncthreads();
}
}

namespace gla {
constexpr int QROW = 272, SROW = 144;
constexpr int OFF_QT = 0, OFF_KT = 17408, OFF_KTT = 34816, OFF_VT = 53248, OFF_ST = 62464, OFF_AM = 79872, OFF_TOT = 89088, OFF_GM = 91136, OFF_GL = 91648;
__device__ __forceinline__ void gla_unit(LAS char* lds, int seqbase, int T, int hd, int dir, int vh, const float* F, const bf16_t* QH, const bf16_t* I, bf16_t* OH) {
    int tid_ = threadIdx.x; asm volatile("" : "+v"(tid_));
    const int tid = tid_, lane = tid & 63, r = lane & 31, hh = lane >> 5, w = __builtin_amdgcn_readfirstlane(tid >> 6);
    const int c = tid & 127, seg = tid >> 7, vc = tid & 63, vseg = tid >> 6;
    const int kt = w >> 1, vt = w & 1;
    f32x16 S;
#pragma unroll
    for (int i = 0; i < 16; ++i) S[i] = 0.f;
    LAS float* TOT = (LAS float*)(lds + OFF_TOT); LAS float* GM = (LAS float*)(lds + OFF_GM); LAS float* GL = (LAS float*)(lds + OFF_GL);
    const int NC = T / 64;
    for (int n = 0; n < NC; ++n) {
        float g[16], qv[16], kv[16]; float run = 0.f;
#pragma unroll
        for (int j = 0; j < 16; ++j) { const int t = 64 * n + 16 * seg + j; const size_t row = (size_t)seqbase + (dir ? T - 1 - t : t);
            const float f = F[row * 1024 + dir * 512 + hd * 128 + c]; qv[j] = bf2f(QH[row * 512 + hd * 128 + c]);
            run += __builtin_amdgcn_logf(f); g[j] = run; kv[j] = 1.f - f; }
        unsigned short vv[8];
#pragma unroll
        for (int j = 0; j < 8; ++j) { const int t = 64 * n + 8 * vseg + j; const size_t row = (size_t)seqbase + (dir ? T - 1 - t : t); vv[j] = I[row * 512 + hd * 128 + vh * 64 + vc]; }
        TOT[seg * 128 + c] = run;
        __syncthreads();
        const float t0 = TOT[c], t1 = TOT[128 + c], t2 = TOT[256 + c], t3 = TOT[384 + c];
        const float gbase = (seg > 0 ? t0 : 0.f) + (seg > 1 ? t1 : 0.f) + (seg > 2 ? t2 : 0.f);
        const float gmid = t0 + t1, glast = (t0 + t1) + (t2 + t3);
        unsigned kp[8];
#pragma unroll
        for (int j = 0; j < 16; j += 2) {
            const float ga = g[j] + gbase - gmid, gb = g[j + 1] + gbase - gmid;
            const float qa = qv[j] * ex2(ga), qb = qv[j + 1] * ex2(gb), ka = kv[j] * ex2(-ga), kb2 = kv[j + 1] * ex2(-gb);
            const unsigned qw = cvtpk(qa, qb), kw = cvtpk(ka, kb2);
            *(LAS unsigned short*)(lds + OFF_QT + (16 * seg + j) * QROW + c * 2) = (unsigned short)(qw & 0xffffu);
            *(LAS unsigned short*)(lds + OFF_QT + (16 * seg + j + 1) * QROW + c * 2) = (unsigned short)(qw >> 16);
            *(LAS unsigned short*)(lds + OFF_KT + (16 * seg + j) * QROW + c * 2) = (unsigned short)(kw & 0xffffu);
            *(LAS unsigned short*)(lds + OFF_KT + (16 * seg + j + 1) * QROW + c * 2) = (unsigned short)(kw >> 16);
            kp[j >> 1] = kw;
        }
        *(LAS u32x4*)(lds + OFF_KTT + c * SROW + seg * 32) = (u32x4){kp[0], kp[1], kp[2], kp[3]};
        *(LAS u32x4*)(lds + OFF_KTT + c * SROW + seg * 32 + 16) = (u32x4){kp[4], kp[5], kp[6], kp[7]};
        *(LAS u32x4*)(lds + OFF_VT + vc * SROW + vseg * 16) = (u32x4){(unsigned)vv[0] | ((unsigned)vv[1] << 16), (unsigned)vv[2] | ((unsigned)vv[3] << 16), (unsigned)vv[4] | ((unsigned)vv[5] << 16), (unsigned)vv[6] | ((unsigned)vv[7] << 16)};
        if (seg == 0) { GM[c] = gmid; GL[c] = glast; }
        __syncthreads();
#pragma unroll
        for (int gq = 0; gq < 4; ++gq) { const int k = 32 * kt + 8 * gq + 4 * hh; const f32x4 gm = *(const LAS f32x4*)(GM + k);
            u32x2 wv; wv.x = cvtpk(S[4 * gq] * ex2(gm[0]), S[4 * gq + 1] * ex2(gm[1])); wv.y = cvtpk(S[4 * gq + 2] * ex2(gm[2]), S[4 * gq + 3] * ex2(gm[3]));
            *(LAS u32x2*)(lds + OFF_ST + (32 * vt + r) * QROW + k * 2) = wv; }
        if (w < 4) {
            const int st = w >> 1, tt = w & 1; f32x16 a;
#pragma unroll
            for (int i = 0; i < 16; ++i) a[i] = 0.f;
#pragma unroll
            for (int ks = 0; ks < 8; ++ks) {
                const bf16x8 af = *(const LAS bf16x8*)(lds + OFF_KT + (32 * st + r) * QROW + (16 * ks + 8 * hh) * 2), bfr = *(const LAS bf16x8*)(lds + OFF_QT + (32 * tt + r) * QROW + (16 * ks + 8 * hh) * 2);
                a = MFMA32(af, bfr, a);
            }
            const int tq = 32 * tt + r;
#pragma unroll
            for (int gq = 0; gq < 4; ++gq) { const int s = 32 * st + 8 * gq + 4 * hh;
                const float a0 = (s + 0 <= tq) ? a[4 * gq] : 0.f, a1 = (s + 1 <= tq) ? a[4 * gq + 1] : 0.f, a2 = (s + 2 <= tq) ? a[4 * gq + 2] : 0.f, a3 = (s + 3 <= tq) ? a[4 * gq + 3] : 0.f;
                u32x2 wv; wv.x = cvtpk(a0, a1); wv.y = cvtpk(a2, a3);
                *(LAS u32x2*)(lds + OFF_AM + tq * SROW + s * 2) = wv; }
        }
        __syncthreads();
        if (w < 4) {
            const int tt = w >> 1, v2 = w & 1; f32x16 oo;
#pragma unroll
            for (int i = 0; i < 16; ++i) oo[i] = 0.f;
#pragma unroll
            for (int ks = 0; ks < 8; ++ks) {
                const bf16x8 af = *(const LAS bf16x8*)(lds + OFF_QT + (32 * tt + r) * QROW + (16 * ks + 8 * hh) * 2), bfr = *(const LAS bf16x8*)(lds + OFF_ST + (32 * v2 + r) * QROW + (16 * ks + 8 * hh) * 2);
                oo = MFMA32(af, bfr, oo);
            }
#pragma unroll
            for (int ks = 0; ks < 4; ++ks) {
                const bf16x8 af = *(const LAS bf16x8*)(lds + OFF_AM + (32 * tt + r) * SROW + (16 * ks + 8 * hh) * 2), bfr = *(const LAS bf16x8*)(lds + OFF_VT + (32 * v2 + r) * SROW + (16 * ks + 8 * hh) * 2);
                oo = MFMA32(af, bfr, oo);
            }
#pragma unroll
            for (int i = 0; i < 16; ++i) { const int t = 64 * n + 32 * tt + crow(i, hh); const size_t row = (size_t)seqbase + (dir ? T - 1 - t : t);
                OH[row * 512 + hd * 128 + vh * 64 + 32 * v2 + r] = (unsigned short)(cvtpk(oo[i], 0.f) & 0xffffu); }
        }
        {
            f32x16 ds;
#pragma unroll
            for (int i = 0; i < 16; ++i) ds[i] = 0.f;
#pragma unroll
            for (int ks = 0; ks < 4; ++ks) {
                const bf16x8 af = *(const LAS bf16x8*)(lds + OFF_KTT + (32 * kt + r) * SROW + (16 * ks + 8 * hh) * 2), bfr = *(const LAS bf16x8*)(lds + OFF_VT + (32 * vt + r) * SROW + (16 * ks + 8 * hh) * 2);
                ds = MFMA32(af, bfr, ds);
            }
#pragma unroll
            for (int gq = 0; gq < 4; ++gq) { const int k = 32 * kt + 8 * gq + 4 * hh; const f32x4 gl = *(const LAS f32x4*)(GL + k), gm = *(const LAS f32x4*)(GM + k);
#pragma unroll
                for (int e = 0; e < 4; ++e) S[4 * gq + e] = S[4 * gq + e] * ex2(gl[e]) + ds[4 * gq + e] * ex2(gl[e] - gm[e]); }
        }
        __syncthreads();
    }
}
}

__global__ void __launch_bounds__(512, 2) fwd_megakernel(Args args) {
    extern __shared__ __attribute__((aligned(16))) unsigned char lds_raw[];
    cg::grid_group grid = cg::this_grid();
    LAS unsigned char* lds = (LAS unsigned char*)lds_raw;
    const int tid = threadIdx.x, lane = tid & 63, wave = __builtin_amdgcn_readfirstlane(tid >> 6);
    const int G = gridDim.x, bx = blockIdx.x;
    unsigned char* ws = args.ws;
    const float* x_p = args.in[0]; const float* x_s = args.in[1]; const float* norm1 = args.in[2]; const float* w_in = args.in[3]; const float* lbl = args.in[4];
    const float* hg_norm = args.in[5]; const float* w_hg = args.in[6]; const float* lq1 = args.in[7]; const float* lk1 = args.in[8]; const float* lq2 = args.in[9]; const float* lk2 = args.in[10];
    const float* subln = args.in[11]; const float* w_da = args.in[12]; const float* w_out = args.in[13]; const float* norm2 = args.in[14]; const float* w_m1 = args.in[15]; const float* w_m2 = args.in[16];
    const float* fnorm = args.in[17];
    float* out = args.out;
    unsigned* ctl = (unsigned*)(ws + WS_CTL); float* rope = (float*)(ws + WS_ROPE); float* PART = (float*)(ws + WS_PART);
    bf16_t* Wb = (bf16_t*)(ws + WS_W); bf16_t* XN = (bf16_t*)(ws + WS_XN); bf16_t* OHF = (bf16_t*)(ws + WS_OHF); bf16_t* OHB = (bf16_t*)(ws + WS_OHB);
    bf16_t* Qb = (bf16_t*)(ws + WS_Q); bf16_t* Kb = (bf16_t*)(ws + WS_K); bf16_t* Vb = (bf16_t*)(ws + WS_V); bf16_t* QH = (bf16_t*)(ws + WS_QH); bf16_t* Ib = (bf16_t*)(ws + WS_I);
    bf16_t* Gb = (bf16_t*)(ws + WS_G); float* Fb = (float*)(ws + WS_F); bf16_t* MB = (bf16_t*)(ws + WS_MB); bf16_t* HID = (bf16_t*)(ws + WS_HID);
    bf16_t* GATES = (bf16_t*)out;
    const int gw = bx * 8 + wave, NGW = G * 8;

    {
        LAS float* scr = (LAS float*)(lds + wave * 8448);
        constexpr int I_IN = 16 * 192, I_HG = 8 * 32, I_DA = 8 * 32, I_OUT = 16 * 32, I_M1 = 16 * 128, I_M2 = 64 * 32;
        constexpr int NITEMS = I_IN + I_HG + I_DA + I_OUT + I_M1 + I_M2;
        for (int it = gw; it < NITEMS; it += NGW) {
            int q = it;
            if (q < I_IN) { transpose_item(w_in, 1024, INW, Wb + W_IN, nullptr, scr, q, lane); continue; } q -= I_IN;
            if (q < I_HG) { transpose_item(w_hg, 512, 1024, Wb + W_HG, nullptr, scr, q, lane); continue; } q -= I_HG;
            if (q < I_DA) { transpose_item(w_da, 512, 1024, Wb + W_DA, nullptr, scr, q, lane); continue; } q -= I_DA;
            if (q < I_OUT) { transpose_item(w_out, 1024, 1024, Wb + W_OUT, nullptr, scr, q, lane); continue; } q -= I_OUT;
            if (q < I_M1) { transpose_item(w_m1, 1024, DFF, Wb + W_M1, norm2, scr, q, lane); continue; } q -= I_M1;
            transpose_item(w_m2, DFF, 1024, Wb + W_M2, nullptr, scr, q, lane);
        }
        for (int m = gw; m < M; m += NGW) {
            const float* xr = m < MP ? x_p + (size_t)m * 1024 : x_s + (size_t)(m - MP) * 1024;
            f32x4 v[4]; float s = 0.f;
#pragma unroll
            for (int j = 0; j < 4; ++j) { v[j] = *(const f32x4*)(xr + 4 * lane + 256 * j); s += (v[j][0] * v[j][0] + v[j][1] * v[j][1]) + (v[j][2] * v[j][2] + v[j][3] * v[j][3]); }
            const float rstd = 1.f / sqrtf(wave_sum(s) * (1.f / 1024.f) + 1e-6f);
#pragma unroll
            for (int j = 0; j < 4; ++j) { const f32x4 gn = *(const f32x4*)(norm1 + 4 * lane + 256 * j);
                u32x2 o; o.x = cvtpk(v[j][0] * rstd * gn[0], v[j][1] * rstd * gn[1]); o.y = cvtpk(v[j][2] * rstd * gn[2], v[j][3] * rstd * gn[3]);
                *(u32x2*)(XN + (size_t)m * 1024 + 4 * lane + 256 * j) = o; }
        }
        for (int e = bx * 512 + tid; e < TS * 8; e += G * 512) { const int pos = e >> 3, j = e & 7;
            const float invf = exp2f(-(float)j * (18.931568569324174f / 8.f));
            const float ang = (float)pos * invf; float sn, cs; sincosf(ang, &sn, &cs);
            rope[(size_t)pos * 16 + 2 * j] = cs; rope[(size_t)pos * 16 + 2 * j + 1] = sn; }
        if (bx == 0) ctl[tid] = 0u;
    }
    grid.sync();

    {
        pg8::Gemm g{XN, Wb + W_IN, M, INW, 1024}; pg8::StaticOrder S; S.init(M, INW, G, bx);
        epi::EpiIn E{Qb, Kb, Vb, QH, Ib, Gb, GATES, Fb, lbl, rope};
        pg8::gemm_phase<epi::EpiIn, pg8::StaticOrder, true, true>(lds, g, S, E);
    }
    grid.sync();

    {
        for (int u = bx; u < 256; u += G) {
            const int grp = u >> 7, uu = u & 127, seq = uu >> 4, hd = (uu >> 2) & 3, dir = (uu >> 1) & 1, vh = uu & 1;
            const int T = grp == 0 ? TS : TP, seqbase = grp == 0 ? MP + seq * TS : seq * TP;
            gla::gla_unit((LAS char*)lds, seqbase, T, hd, dir, vh, Fb, QH, Ib, dir ? OHB : OHF);
        }
        LAS float* misc = (LAS float*)(lds + att::OFF_MISC);
        if (wave == 0) {
            const float a = wave_sum(lq1[lane] * lk1[lane]), b = wave_sum(lq2[lane] * lk2[lane]);
            if (lane == 0) misc[0] = expf(a) - expf(b) + 0.2f;
        }
        __syncthreads();
        const float lam = misc[0];
        constexpr int NQ_S = 4 * (TS / 128), NQ = NQ_S + 4 * (TP / 128);
        const int xcc = (int)((unsigned)__builtin_amdgcn_s_getreg((3 << 11) | 20) & 7u);
        for (int k = 0; k < 8; ++k) {
            const int x = (xcc + k) & 7;
            for (;;) {
                __syncthreads();
                if (tid == 0) ((LAS unsigned*)misc)[1] = atomicAdd(ctl + 64 * x, 1u);
                __syncthreads();
                const int i = (int)((LAS unsigned*)misc)[1];
                if (i >= NQ) break;
                int seqbase, T, h, qb;
                if (i < NQ_S) { h = i >> 6; qb = i & 63; T = TS; seqbase = MP + x * TS; }
                else { const int j = i - NQ_S; h = j >> 4; qb = j & 15; T = TP; seqbase = x * TP; }
                att::attn_unit((LAS char*)lds, seqbase, T, h, qb, Qb, Kb, Vb, Qb  , lam, subln);
            }
        }
    }
    grid.sync();

    for (int m = gw; m < M; m += NGW) {
        const size_t off = (size_t)m * 512 + 8 * lane;
        const u32x4 a = *(const u32x4*)(OHF + off), b = *(const u32x4*)(OHB + off), gg = *(const u32x4*)(Gb + off);
        float v[8] = {bflo(a.x) + bflo(b.x), bfhi(a.x) + bfhi(b.x), bflo(a.y) + bflo(b.y), bfhi(a.y) + bfhi(b.y), bflo(a.z) + bflo(b.z), bfhi(a.z) + bfhi(b.z), bflo(a.w) + bflo(b.w), bfhi(a.w) + bfhi(b.w)};
        float ss = 0.f;
#pragma unroll
        for (int e = 0; e < 8; ++e) ss += v[e] * v[e];
        ss += __shfl_xor(ss, 1); ss += __shfl_xor(ss, 2); ss += __shfl_xor(ss, 4); ss += __shfl_xor(ss, 8);
        const float rs = 1.f / sqrtf(ss * (1.f / 128.f) + 1e-6f);
        const f32x4 n0 = *(const f32x4*)(hg_norm + 8 * lane), n1 = *(const f32x4*)(hg_norm + 8 * lane + 4);
        const float gv[8] = {bflo(gg.x), bfhi(gg.x), bflo(gg.y), bfhi(gg.y), bflo(gg.z), bfhi(gg.z), bflo(gg.w), bfhi(gg.w)};
        u32x4 o; o.x = cvtpk(v[0] * rs * n0[0] * gv[0], v[1] * rs * n0[1] * gv[1]); o.y = cvtpk(v[2] * rs * n0[2] * gv[2], v[3] * rs * n0[3] * gv[3]);
        o.z = cvtpk(v[4] * rs * n1[0] * gv[4], v[5] * rs * n1[1] * gv[5]); o.w = cvtpk(v[6] * rs * n1[2] * gv[6], v[7] * rs * n1[3] * gv[7]);
        *(u32x4*)(OHF + off) = o;
    }
    grid.sync();

    {
        pg8::StaticOrder S; S.init(M, 1024, G, bx);
        { pg8::Gemm g{OHF, Wb + W_HG, M, 1024, 512}; epi::EpiGate<0> E{GATES, MB}; pg8::gemm_phase<epi::EpiGate<0>, pg8::StaticOrder, true, true>(lds, g, S, E); }
        __syncthreads();
        { pg8::Gemm g{Qb, Wb + W_DA, M, 1024, 512}; epi::EpiGate<1> E{GATES, MB}; pg8::gemm_phase<epi::EpiGate<1>, pg8::StaticOrder, true, true>(lds, g, S, E); }
    }
    grid.sync();

    {
        pg8::Gemm g{MB, Wb + W_OUT, M, 1024, 1024}; pg8::StaticOrder S; S.init(M, 1024, G, bx);
        epi::EpiRes<true> E{x_p, x_s, out, XN, PART};
        pg8::gemm_phase<epi::EpiRes<true>, pg8::StaticOrder, true, true>(lds, g, S, E);
    }
    grid.sync();

    {
        pg8::Gemm g{XN, Wb + W_M1, M, DFF, 1024}; pg8::StaticOrder S; S.init(M, DFF, G, bx);
        epi::EpiMlpIn E{PART, HID};
        pg8::gemm_phase<epi::EpiMlpIn, pg8::StaticOrder, true, true>(lds, g, S, E);
    }
    grid.sync();

    {
        pg8::Gemm g{HID, Wb + W_M2, M, 1024, DFF}; pg8::StaticOrder S; S.init(M, 1024, G, bx);
        epi::EpiRes<false> E{nullptr, nullptr, out, nullptr, PART};
        pg8::gemm_phase<epi::EpiRes<false>, pg8::StaticOrder, true, true>(lds, g, S, E);
    }
    grid.sync();

    for (int m = gw; m < M; m += NGW) {
        const f32x4* pp = (const f32x4*)(PART + (size_t)m * 16); const f32x4 p0 = pp[0], p1 = pp[1], p2 = pp[2], p3 = pp[3];
        const float s = ((p0[0] + p0[1]) + (p0[2] + p0[3])) + ((p1[0] + p1[1]) + (p1[2] + p1[3])) + ((p2[0] + p2[1]) + (p2[2] + p2[3])) + ((p3[0] + p3[1]) + (p3[2] + p3[3]));
        const float rstd = 1.f / sqrtf(s * (1.f / 1024.f) + 1e-6f);
        float* orow = out + (size_t)m * 1024;
#pragma unroll
        for (int j = 0; j < 4; ++j) { f32x4 v = *(const f32x4*)(orow + 4 * lane + 256 * j); const f32x4 gn = *(const f32x4*)(fnorm + 4 * lane + 256 * j);
            v = v * rstd * gn; *(f32x4*)(orow + 4 * lane + 256 * j) = v; }
    }
}

extern "C" void kernel_launch(void* const* d_in, const int* in_sizes, int n_in, void* d_out, int out_size, void* d_ws, size_t ws_size, hipStream_t stream) {
    static int grid = 0;
    if (grid == 0) {
        if (n_in != 18 || out_size != M * DM || ws_size < WS_END) { fprintf(stderr, "kernel_launch: unexpected sizes n_in %d out %d ws %zu\n", n_in, out_size, ws_size); grid = -1; return; }
        int dev = 0, cus = 0, per_cu = 0;
        hipGetDevice(&dev); hipDeviceGetAttribute(&cus, hipDeviceAttributeMultiprocessorCount, dev);
        hipFuncSetAttribute((const void*)fwd_megakernel, hipFuncAttributeMaxDynamicSharedMemorySize, LDS_BYTES);
        hipOccupancyMaxActiveBlocksPerMultiprocessor(&per_cu, (const void*)fwd_megakernel, 512, LDS_BYTES);
        if (per_cu < 1) per_cu = 1;
        (void)hipGetLastError();
        grid = cus * per_cu;
    }
    if (grid < 0) return;
    Args a{};
    for (int i = 0; i < 18; ++i) a.in[i] = (const float*)d_in[i];
    a.out = (float*)d_out; a.ws = (unsigned char*)d_ws; a.grid_expect = grid; a.pad = 0;
    void* kargs[] = {&a};
    hipError_t e = hipLaunchCooperativeKernel((const void*)fwd_megakernel, dim3(grid), dim3(512), kargs, LDS_BYTES, stream);
    if (e != hipSuccess) fprintf(stderr, "cooperative launch failed: %s (grid %d)\n", hipGetErrorString(e), grid);
}
```
